# Optimizing an MI355X kernel written in HIP

```python
import math
import jax, jax.numpy as jnp
from jax import lax
import numpy as np

D_MODEL = 1024
BATCH = 4
SEQ = 4096
DEPTH = 1

CTX_LEN = 256
GRID_W = 64
F_GROUPS = 4
F_GROUP_DIM = 128
F_DIM = F_GROUPS * F_GROUP_DIM
NQK_HEADS = 4
NV_HEADS = 8
DK = 128
DV = 128
QK_DIM = NQK_HEADS * DK
V_DIM = NV_HEADS * DV
QKV_DIM = 2 * QK_DIM + V_DIM
CONV_K = 3
CHUNK = 64
BETA_OFF = QKV_DIM
A_OFF = BETA_OFF + 2 * NV_HEADS
GDN_IN_COLS = A_OFF + 2 * NV_HEADS
Z_OFF = GDN_IN_COLS
F_OFF = Z_OFF + V_DIM
GA_OFF = F_OFF + F_DIM
GB_OFF = GA_OFF + D_MODEL
IN_COLS = GB_OFF + D_MODEL
N_EXPERTS = 32
TOP_K = 4
D_EXPERT = D_MODEL
SWIGLU_ALPHA = 1.702
SWIGLU_LIMIT = 7.0
MOE_BLOCK = 128
EPS = 1e-6

kernel_name = 'hybrid_fnet_gdn_moe_dit_block'


def rmsnorm(x, g):
    xf = x.astype(jnp.float32)
    y = xf * lax.rsqrt(jnp.mean(xf * xf, axis=-1, keepdims=True) + EPS)
    return (y * g.astype(jnp.float32)).astype(x.dtype)


def modulate(h, shift, scale):
    return h * (1.0 + scale) + shift


def l2norm(t):
    t = t.astype(jnp.float32)
    return t * lax.rsqrt(jnp.sum(t * t, axis=-1, keepdims=True) + EPS)


def short_conv_grid(t, w, rows):
    B, L, C = t.shape
    y = lax.conv_general_dilated(t.reshape(B, rows, GRID_W, C), w[:, :, None, :], (1, 1), 'SAME',
                                 dimension_numbers=('NHWC', 'HWIO', 'NHWC'), feature_group_count=C)
    return y.reshape(B, L, C)


def short_conv_seq(t, w):
    C = t.shape[-1]
    return lax.conv_general_dilated(t, w[CONV_K // 2][:, None, :], (1,), 'SAME',
                                    dimension_numbers=('NWC', 'WIO', 'NWC'), feature_group_count=C)


def gdn_inputs(p, conv_w, rows):
    B, L, _ = p.shape
    qkv = p[..., :QKV_DIM]
    qkv = jax.nn.silu(short_conv_grid(qkv, conv_w, rows) if rows is not None else short_conv_seq(qkv, conv_w))
    rep = NV_HEADS // NQK_HEADS
    q = jnp.repeat(l2norm(qkv[..., :QK_DIM].reshape(B, L, NQK_HEADS, DK)) * DK ** -0.5, rep, axis=2)
    k = jnp.repeat(l2norm(qkv[..., QK_DIM:2 * QK_DIM].reshape(B, L, NQK_HEADS, DK)), rep, axis=2)
    v = qkv[..., 2 * QK_DIM:].reshape(B, L, NV_HEADS, DV)
    beta = jax.nn.sigmoid(p[..., BETA_OFF:A_OFF].astype(jnp.float32)).reshape(B, L, 2, NV_HEADS)
    a_raw = p[..., A_OFF:GDN_IN_COLS].astype(jnp.float32).reshape(B, L, 2, NV_HEADS)
    return q, k, v, a_raw, beta


def chunk_gated_delta(q, k, v, log_g, beta, s0):
    B, L, H, _ = q.shape
    n = L // CHUNK
    f32 = jnp.float32

    def blocks(t):
        t = t.astype(f32).reshape((B, n, CHUNK, H) + t.shape[3:])
        return jnp.moveaxis(t, 3, 1)

    qc, kc, vc, bc = blocks(q), blocks(k), blocks(v), blocks(beta)
    gc = jnp.cumsum(blocks(log_g), axis=-1)
    incl = jnp.tril(jnp.ones((CHUNK, CHUNK), bool))
    strict = jnp.tril(jnp.ones((CHUNK, CHUNK), bool), -1)
    decay = jnp.exp(jnp.where(incl, gc[..., :, None] - gc[..., None, :], -jnp.inf))
    kk = jnp.einsum('bhnid,bhnjd->bhnij', kc, kc)
    lower = jnp.where(strict, bc[..., :, None] * kk * decay, 0.0)
    rhs = jnp.concatenate([bc[..., None] * vc, (bc * jnp.exp(gc))[..., None] * kc], axis=-1)
    sol = lax.linalg.triangular_solve(jnp.eye(CHUNK, dtype=f32) + lower, rhs,
                                      left_side=True, lower=True, unit_diagonal=True)
    u_new, w = sol[..., :DV], sol[..., DV:]
    qk = jnp.einsum('bhnid,bhnjd->bhnij', qc, kc) * decay
    q_dec = qc * jnp.exp(gc)[..., None]
    g_end = gc[..., -1]
    k_dec = kc * jnp.exp(g_end[..., None] - gc)[..., None]

    def step(S, xs):
        u_c, w_c, qk_c, qd_c, kd_c, ge_c = xs
        u = u_c - jnp.einsum('bhck,bhkv->bhcv', w_c, S)
        o = jnp.einsum('bhck,bhkv->bhcv', qd_c, S) + jnp.einsum('bhij,bhjv->bhiv', qk_c, u)
        S = jnp.exp(ge_c)[..., None, None] * S + jnp.einsum('bhck,bhcv->bhkv', kd_c, u)
        return S, o

    xs = tuple(jnp.moveaxis(t, 2, 0) for t in (u_new, w, qk, q_dec, k_dec, g_end))
    s_fin, o = lax.scan(step, s0.astype(f32), xs)
    o = jnp.moveaxis(jnp.moveaxis(o, 0, 2), 1, 3).reshape(B, L, H, DV)
    return o, s_fin


def gdn_bidir(q, k, v, a_raw, beta, a_log, dt_bias, s0_f, s0_b):
    log_g = -jnp.exp(a_log.astype(jnp.float32)) * jax.nn.softplus(a_raw + dt_bias.astype(jnp.float32))
    o_f, s_f = chunk_gated_delta(q, k, v, log_g[:, :, 0], beta[:, :, 0], s0_f)
    flip = lambda t: jnp.flip(t, axis=1)
    o_b, s_b = chunk_gated_delta(flip(q), flip(k), flip(v), flip(log_g[:, :, 1]), flip(beta[:, :, 1]), s0_b)
    return o_f + flip(o_b), s_f, s_b


def fourier_mix(f):
    B, L, _ = f.shape
    fg = f.astype(jnp.float32).reshape(B, L, F_GROUPS, F_GROUP_DIM)
    return jnp.fft.fftn(fg, axes=(1, 3), norm='ortho').real.reshape(B, L, F_DIM).astype(f.dtype)


def merge_branches(p, o, gdn_norm_g, w_fourier_out, w_gdn_out, w_merge_out):
    B, L, _ = p.shape
    z = p[..., Z_OFF:F_OFF].astype(jnp.float32).reshape(B, L, NV_HEADS, DV)
    yb = o * lax.rsqrt(jnp.mean(o * o, axis=-1, keepdims=True) + EPS) * gdn_norm_g.astype(jnp.float32) * jax.nn.silu(z)
    yb = yb.reshape(B, L, V_DIM).astype(p.dtype) @ w_gdn_out
    ya = fourier_mix(p[..., F_OFF:GA_OFF]) @ w_fourier_out
    ga = jax.nn.sigmoid(p[..., GA_OFF:GB_OFF])
    gb = jax.nn.sigmoid(p[..., GB_OFF:IN_COLS])
    return (ga * ya + gb * yb) @ w_merge_out


def moe_ffn(h, w_router, b_router, w_gate, b_gate, w_up, b_up, w_down, b_down):
    N, D = h.shape
    logits = h.astype(jnp.float32) @ w_router.astype(jnp.float32) + b_router.astype(jnp.float32)
    top_val, top_idx = lax.top_k(logits, TOP_K)
    top_w = jax.nn.softmax(top_val, axis=-1)
    flat_e = top_idx.reshape(-1)
    flat_tok = jnp.repeat(jnp.arange(N, dtype=jnp.int32), TOP_K)
    order = jnp.argsort(flat_e)
    e_sorted = flat_e[order]
    counts = jnp.bincount(flat_e, length=N_EXPERTS)
    padded = (counts + MOE_BLOCK - 1) // MOE_BLOCK * MOE_BLOCK
    pad_end = jnp.cumsum(padded)
    pad_start = pad_end - padded
    grp_start = jnp.cumsum(counts) - counts
    dest = pad_start[e_sorted] + jnp.arange(N * TOP_K, dtype=jnp.int32) - grp_start[e_sorted]
    n_blocks = -(-(N * TOP_K + N_EXPERTS * (MOE_BLOCK - 1)) // MOE_BLOCK)
    n_slots = n_blocks * MOE_BLOCK
    slot_tok = jnp.full((n_slots,), N, jnp.int32).at[dest].set(flat_tok[order])
    slot_w = jnp.zeros((n_slots,), jnp.float32).at[dest].set(top_w.reshape(-1)[order])
    block_e = jnp.minimum(jnp.searchsorted(pad_end, jnp.arange(n_blocks, dtype=jnp.int32) * MOE_BLOCK, side='right'),
                          N_EXPERTS - 1)
    h_pad = jnp.concatenate([h, jnp.zeros((1, D), h.dtype)], axis=0)
    xb = h_pad[slot_tok].reshape(n_blocks, MOE_BLOCK, D)

    def expert_block(args):
        xe, e = args
        gate = jnp.minimum(xe @ w_gate[e] + b_gate[e], SWIGLU_LIMIT)
        up = jnp.clip(xe @ w_up[e] + b_up[e], -SWIGLU_LIMIT, SWIGLU_LIMIT)
        act = (up + 1.0) * gate * jax.nn.sigmoid(SWIGLU_ALPHA * gate)
        return act @ w_down[e] + b_down[e]

    yb = lax.map(expert_block, (xb, block_e)).reshape(n_slots, D)
    out = jnp.zeros((N + 1, D), jnp.float32).at[slot_tok].add(yb.astype(jnp.float32) * slot_w[:, None])
    return out[:N].astype(h.dtype)


def setup_inputs(seed: int = 0) -> dict:
    key = jax.random.key(seed)
    ks = jax.random.split(key, 32)
    D = D_MODEL
    nrm = lambda k, shape, s: jax.random.normal(k, shape, jnp.float32) * s
    dt = jnp.exp(jax.random.uniform(ks[11], (DEPTH, 2, NV_HEADS), jnp.float32, math.log(1e-3), math.log(1e-1)))
    return {
        'x': nrm(ks[0], (BATCH, SEQ, D), 1.0),
        'c': nrm(ks[1], (BATCH, D), 1.0),
        'ctx': nrm(ks[2], (BATCH, CTX_LEN, D), 1.0),
        'c_ctx': nrm(ks[3], (D,), 1.0),
        'w_mod': nrm(ks[4], (DEPTH, D, 6 * D), 0.5 * D ** -0.5),
        'b_mod': nrm(ks[5], (DEPTH, 6 * D), 0.02),
        'norm1_g': 1.0 + nrm(ks[6], (DEPTH, D), 0.05),
        'norm2_g': 1.0 + nrm(ks[7], (DEPTH, D), 0.05),
        'w_in': nrm(ks[8], (DEPTH, D, IN_COLS), D ** -0.5),
        'conv_w': nrm(ks[9], (DEPTH, CONV_K, CONV_K, QKV_DIM), 1.0 / CONV_K),
        'a_log': jnp.log(jax.random.uniform(ks[10], (DEPTH, 2, NV_HEADS), jnp.float32, 1.0, 16.0)),
        'dt_bias': dt + jnp.log(-jnp.expm1(-dt)),
        'gdn_norm_g': 1.0 + nrm(ks[12], (DEPTH, DV), 0.05),
        'w_fourier_out': nrm(ks[13], (DEPTH, F_DIM, D), F_DIM ** -0.5),
        'w_gdn_out': nrm(ks[14], (DEPTH, V_DIM, D), V_DIM ** -0.5),
        'w_merge_out': nrm(ks[15], (DEPTH, D, D), D ** -0.5),
        'w_router': nrm(ks[16], (DEPTH, D, N_EXPERTS), D ** -0.5),
        'b_router': nrm(ks[17], (DEPTH, N_EXPERTS), 0.01),
        'w_gate': nrm(ks[18], (DEPTH, N_EXPERTS, D, D_EXPERT), D ** -0.5),
        'b_gate': nrm(ks[19], (DEPTH, N_EXPERTS, D_EXPERT), 0.01),
        'w_up': nrm(ks[20], (DEPTH, N_EXPERTS, D, D_EXPERT), D ** -0.5),
        'b_up': nrm(ks[21], (DEPTH, N_EXPERTS, D_EXPERT), 0.01),
        'w_down': nrm(ks[22], (DEPTH, N_EXPERTS, D_EXPERT, D), D_EXPERT ** -0.5),
        'b_down': nrm(ks[23], (DEPTH, N_EXPERTS, D), 0.01),
        'final_norm_g': 1.0 + nrm(ks[24], (D,), 0.05),
    }


def reference(x, c, ctx, c_ctx, w_mod, b_mod, norm1_g, norm2_g, w_in, conv_w, a_log, dt_bias, gdn_norm_g,
              w_fourier_out, w_gdn_out, w_merge_out, w_router, b_router, w_gate, b_gate, w_up, b_up,
              w_down, b_down, final_norm_g):
    B, L, D = x.shape
    rows = L // GRID_W
    h_ctx = ctx
    for l in range(DEPTH):
        last = l == DEPTH - 1
        mod = (jax.nn.silu(c) @ w_mod[l] + b_mod[l])[:, None, :]
        sh1, sc1, g1, sh2, sc2, g2 = jnp.split(mod, 6, axis=-1)
        mod_c = jax.nn.silu(c_ctx) @ w_mod[l] + b_mod[l]
        csh1, csc1, cg1, csh2, csc2, cg2 = jnp.split(mod_c, 6)

        u_ctx = modulate(rmsnorm(h_ctx, norm1_g[l]), csh1, csc1)
        p_ctx = u_ctx @ (w_in[l][:, :GDN_IN_COLS] if last else w_in[l])
        q, k, v, a_raw, beta = gdn_inputs(p_ctx, conv_w[l], None)
        zero = jnp.zeros((B, NV_HEADS, DK, DV), jnp.float32)
        o_ctx, s_f, s_b = gdn_bidir(q, k, v, a_raw, beta, a_log[l], dt_bias[l], zero, zero)

        u = modulate(rmsnorm(x, norm1_g[l]), sh1, sc1)
        p = u @ w_in[l]
        q, k, v, a_raw, beta = gdn_inputs(p, conv_w[l], rows)
        o, _, _ = gdn_bidir(q, k, v, a_raw, beta, a_log[l], dt_bias[l], s_f, s_b)
        x = x + g1 * merge_branches(p, o, gdn_norm_g[l], w_fourier_out[l], w_gdn_out[l], w_merge_out[l])

        h2 = modulate(rmsnorm(x, norm2_g[l]), sh2, sc2)
        x = x + g2 * moe_ffn(h2.reshape(B * L, D), w_router[l], b_router[l], w_gate[l], b_gate[l],
                             w_up[l], b_up[l], w_down[l], b_down[l]).reshape(B, L, D)

        if not last:
            h_ctx = h_ctx + cg1 * merge_branches(p_ctx, o_ctx, gdn_norm_g[l], w_fourier_out[l], w_gdn_out[l], w_merge_out[l])
            hc2 = modulate(rmsnorm(h_ctx, norm2_g[l]), csh2, csc2)
            n_ctx = h_ctx.shape[1]
            h_ctx = h_ctx + cg2 * moe_ffn(hc2.reshape(B * n_ctx, D), w_router[l], b_router[l], w_gate[l], b_gate[l],
                                          w_up[l], b_up[l], w_down[l], b_down[l]).reshape(B, n_ctx, D)
    return rmsnorm(x, final_norm_g)
```

```cpp
#include <hip/hip_runtime.h>
#include <cstdio>
#include <cstdint>

typedef unsigned short u16;

constexpr int D = 1024, NB = 4, L = 4096, NT = NB * L, CT = 256, NC = NB * CT, MR = NT + NC;
constexpr int IN_COLS = 5664;
constexpr int NE = 32, CAP = 16384, SLOTS = 73728;
constexpr float EPS = 1e-6f;

constexpr size_t MiB = 1u << 20;
constexpr size_t WS_CTL = 0;
constexpr size_t WS_MOD = 1 * MiB;
constexpr size_t WS_TOPE = 2 * MiB;
constexpr size_t WS_TOPP = 3 * MiB;
constexpr size_t WS_TOKE = 4 * MiB;
constexpr size_t WS_WTE = 6 * MiB;
constexpr size_t WS_H2 = 8 * MiB;
constexpr size_t WS_B = 40 * MiB;
constexpr size_t WS_U = WS_B;
constexpr size_t WS_OB = WS_U;
constexpr size_t WS_QKV = WS_U + 34 * MiB;
constexpr size_t WS_T1 = WS_QKV;
constexpr size_t WS_BA = WS_QKV + 68 * MiB;
constexpr size_t WS_SZ = WS_BA + 3 * MiB;
constexpr size_t WS_GA = WS_SZ + 32 * MiB;
constexpr size_t WS_GB = WS_GA + 32 * MiB;
constexpr size_t WS_FB = WS_GB + 32 * MiB;
constexpr size_t WS_FT2 = WS_FB + 16 * MiB;
constexpr size_t WS_DFTM = WS_FT2 + 32 * MiB;
constexpr size_t WS_O = WS_DFTM;
constexpr size_t WS_FM = WS_DFTM + 64 * MiB;
constexpr size_t WS_QKVN = WS_FM + 16 * MiB;
constexpr size_t WS_M1 = WS_QKVN;
constexpr size_t WS_END_B = WS_QKVN + 68 * MiB;
constexpr size_t WS_ACT = WS_B;
constexpr size_t WS_Y = WS_B + 144 * MiB;
constexpr size_t WS_NEED = (WS_END_B > WS_Y + 144 * MiB) ? WS_END_B : (WS_Y + 144 * MiB);

__device__ __forceinline__ float bf2f(u16 v) { return __uint_as_float(((unsigned)v) << 16); }
__device__ __forceinline__ u16 f2bf(float f) { unsigned u = __float_as_uint(f); u += 0x7fffu + ((u >> 16) & 1u); return (u16)(u >> 16); }
__device__ __forceinline__ float sigmoidf_(float v) { return 1.f / (1.f + expf(-v)); }
__device__ __forceinline__ float siluf_(float v) { return v / (1.f + expf(-v)); }
__device__ __forceinline__ float softplusf_(float v) { return v > 20.f ? v : log1pf(expf(v)); }
__device__ __forceinline__ float wave_sum(float v) {
#pragma unroll
    for (int o = 1; o < 64; o <<= 1) v += __shfl_xor(v, o);
    return v;
}

__global__ __launch_bounds__(256) void k_mod(const float* __restrict__ c, const float* __restrict__ c_ctx, const float* __restrict__ w_mod,
                                             const float* __restrict__ b_mod, float* __restrict__ MOD) {
    __shared__ float s[5 * 1024];
    for (int i = threadIdx.x; i < 5 * 1024; i += 256) { const int r = i >> 10, k = i & 1023; const float v = r < 4 ? c[r * 1024 + k] : c_ctx[k]; s[i] = siluf_(v); }
    __syncthreads();
    const int n = blockIdx.x * 256 + threadIdx.x;
    if (n >= 6144) return;
    float a0 = 0.f, a1 = 0.f, a2 = 0.f, a3 = 0.f, a4 = 0.f;
    for (int k = 0; k < 1024; ++k) { const float w = w_mod[(size_t)k * 6144 + n]; a0 += s[k] * w; a1 += s[1024 + k] * w; a2 += s[2048 + k] * w; a3 += s[3072 + k] * w; a4 += s[4096 + k] * w; }
    const float bb = b_mod[n];
    MOD[n] = a0 + bb; MOD[6144 + n] = a1 + bb; MOD[2 * 6144 + n] = a2 + bb; MOD[3 * 6144 + n] = a3 + bb; MOD[4 * 6144 + n] = a4 + bb;
}

__global__ __launch_bounds__(256) void k_u(const float* __restrict__ x, const float* __restrict__ ctx, const float* __restrict__ gn, const float* __restrict__ MOD, u16* __restrict__ U) {
    const int row = blockIdx.x * 4 + (threadIdx.x >> 6), lane = threadIdx.x & 63;
    const float* src; int mr;
    if (row < NT) { src = x + (size_t)row * D; mr = row / L; } else { src = ctx + (size_t)(row - NT) * D; mr = 4; }
    float4 v[4]; float ss = 0.f;
#pragma unroll
    for (int j = 0; j < 4; ++j) { v[j] = ((const float4*)src)[lane + 64 * j]; ss += v[j].x * v[j].x + v[j].y * v[j].y + v[j].z * v[j].z + v[j].w * v[j].w; }
    ss = wave_sum(ss);
    const float rstd = rsqrtf(ss * (1.f / D) + EPS);
    const float* sh = MOD + mr * 6144; const float* sc = sh + 1024;
#pragma unroll
    for (int j = 0; j < 4; ++j) {
        const int k = (lane + 64 * j) * 4;
        const float4 g = *(const float4*)(gn + k), s4 = *(const float4*)(sc + k), h4 = *(const float4*)(sh + k);
        ushort4 o;
        o.x = f2bf(v[j].x * rstd * g.x * (1.f + s4.x) + h4.x); o.y = f2bf(v[j].y * rstd * g.y * (1.f + s4.y) + h4.y);
        o.z = f2bf(v[j].z * rstd * g.z * (1.f + s4.z) + h4.z); o.w = f2bf(v[j].w * rstd * g.w * (1.f + s4.w) + h4.w);
        *(ushort4*)(U + (size_t)row * D + k) = o;
    }
}

struct NG { const u16* A; long lda; const int* gather; const void* B; long ldb; int M, N, K, pad; };
template <bool BT>
__device__ __forceinline__ void ngemm_tile(const NG& g, int m0, int n0, float (&acc)[4][4], float* As, float* Bs) {
    const int tx = threadIdx.x & 15, ty = threadIdx.x >> 4;
#pragma unroll
    for (int i = 0; i < 4; ++i)
#pragma unroll
        for (int j = 0; j < 4; ++j) acc[i][j] = 0.f;
    for (int k0 = 0; k0 < g.K; k0 += 16) {
#pragma unroll
        for (int i = 0; i < 4; ++i) {
            const int idx = threadIdx.x + i * 256, r = idx >> 4, kk = idx & 15, m = m0 + r;
            float v = 0.f;
            if (m < g.M) { const long row = g.gather ? (long)g.gather[m] : (long)m; v = bf2f(g.A[row * g.lda + k0 + kk]); }
            As[kk * 65 + r] = v;
        }
        if (!BT) {
#pragma unroll
            for (int i = 0; i < 4; ++i) {
                const int idx = threadIdx.x + i * 256, kk = idx >> 6, cc = idx & 63, n = n0 + cc;
                Bs[kk * 65 + cc] = n < g.N ? ((const float*)g.B)[(long)(k0 + kk) * g.ldb + n] : 0.f;
            }
        } else {
#pragma unroll
            for (int i = 0; i < 4; ++i) {
                const int idx = threadIdx.x + i * 256, cc = idx >> 4, kk = idx & 15, n = n0 + cc;
                Bs[kk * 65 + cc] = n < g.N ? bf2f(((const u16*)g.B)[(long)n * g.ldb + k0 + kk]) : 0.f;
            }
        }
        __syncthreads();
#pragma unroll
        for (int kk = 0; kk < 16; ++kk) {
            float a[4], b[4];
#pragma unroll
            for (int i = 0; i < 4; ++i) { a[i] = As[kk * 65 + ty * 4 + i]; b[i] = Bs[kk * 65 + tx * 4 + i]; }
#pragma unroll
            for (int i = 0; i < 4; ++i)
#pragma unroll
                for (int j = 0; j < 4; ++j) acc[i][j] += a[i] * b[j];
        }
        __syncthreads();
    }
}

template <bool BT, class Epi>
__global__ __launch_bounds__(256) void k_ngemm(NG g, Epi epi, long strideB, long strideOut) {
    __shared__ float As[16 * 65], Bs[16 * 65];
    const int z = blockIdx.z;
    NG gg = g;
    if (BT) gg.B = (const void*)((const u16*)g.B + (size_t)z * strideB); else gg.B = (const void*)((const float*)g.B + (size_t)z * strideB);
    const int m0 = blockIdx.y * 64, n0 = blockIdx.x * 64;
    float acc[4][4];
    ngemm_tile<BT>(gg, m0, n0, acc, As, Bs);
    const int tx = threadIdx.x & 15, ty = threadIdx.x >> 4;
#pragma unroll
    for (int i = 0; i < 4; ++i)
#pragma unroll
        for (int j = 0; j < 4; ++j) { const int m = m0 + ty * 4 + i, n = n0 + tx * 4 + j; if (m < g.M && n < g.N) epi(m + (int)(z * strideOut), n, acc[i][j]); }
}

struct EpiIn {
    u16 *QKV, *SZ, *FB, *GA, *GB; float* BA;
    __device__ void operator()(int m, int n, float v) const {
        if (n < 2048) QKV[(size_t)m * 2048 + n] = f2bf(v);
        else if (n < 2080) BA[(size_t)m * 32 + (n - 2048)] = v;
        else if (m < NT) {
            if (n < 3104) SZ[(size_t)m * 1024 + (n - 2080)] = f2bf(siluf_(v));
            else if (n < 3616) FB[(size_t)m * 512 + (n - 3104)] = f2bf(v);
            else if (n < 4640) GA[(size_t)m * 1024 + (n - 3616)] = f2bf(sigmoidf_(v));
            else GB[(size_t)m * 1024 + (n - 4640)] = f2bf(sigmoidf_(v));
        }
    }
};
struct EpiFM { u16* FM; float scale; int pad; __device__ void operator()(int m, int n, float v) const { FM[(size_t)m * 512 + n] = f2bf(v * scale); } };
struct EpiT1 { u16* T1; const u16* GA; __device__ void operator()(int m, int n, float v) const { const size_t i = (size_t)m * 1024 + n; T1[i] = f2bf(bf2f(GA[i]) * v); } };
struct EpiM1 { u16* M1; const u16* T1; const u16* GB; __device__ void operator()(int m, int n, float v) const { const size_t i = (size_t)m * 1024 + n; M1[i] = f2bf(bf2f(T1[i]) + bf2f(GB[i]) * v); } };
struct EpiX1 { float* X1; const float* x; const float* MOD; __device__ void operator()(int m, int n, float v) const { const size_t i = (size_t)m * 1024 + n; X1[i] = x[i] + MOD[(m / L) * 6144 + 2048 + n] * v; } };

__global__ __launch_bounds__(256) void k_chandft(const u16* __restrict__ FB, u16* __restrict__ FT2) {
    __shared__ float tile[64 * 129];
    __shared__ float ctab[128], stab[128];
    const int lt = blockIdx.x, g = blockIdx.y;
    const int row0 = lt * 64;
    if (threadIdx.x < 128) { ctab[threadIdx.x] = cospif((float)threadIdx.x / 64.f); stab[threadIdx.x] = sinpif((float)threadIdx.x / 64.f); }
    for (int i = threadIdx.x; i < 64 * 128; i += 256) { const int r = i >> 7, c = i & 127; tile[r * 129 + c] = bf2f(FB[(size_t)(row0 + r) * 512 + g * 128 + c]); }
    __syncthreads();
    const int l = threadIdx.x & 63, mq = threadIdx.x >> 6;
    const int b = row0 / L, lpos = (row0 % L) + l;
    for (int mm = 0; mm < 32; ++mm) {
        const int m = mq * 32 + mm;
        float fc = 0.f, fs = 0.f;
        for (int c = 0; c < 128; ++c) { const float v = tile[l * 129 + c]; const int ix = (c * m) & 127; fc += v * ctab[ix]; fs += v * stab[ix]; }
        u16* dst = FT2 + ((size_t)(b * 512 + g * 128 + m)) * 8192 + lpos;
        dst[0] = f2bf(fc); dst[4096] = f2bf(fs);
    }
}
__global__ __launch_bounds__(256) void k_dftm(u16* __restrict__ DFTM) {
    const size_t n = (size_t)4096 * 8192;
    for (size_t i = (size_t)blockIdx.x * 256 + threadIdx.x; i < n; i += (size_t)gridDim.x * 256) {
        const int k = (int)(i >> 13), j = (int)(i & 8191), jj = j & 4095;
        const int ix = (k * jj) & 4095;
        const float a = (float)ix * (1.f / 2048.f);
        DFTM[i] = f2bf(j < 4096 ? cospif(a) : -sinpif(a));
    }
}

__global__ __launch_bounds__(256) void k_conv(const u16* __restrict__ QKV, const float* __restrict__ conv_w, u16* __restrict__ QKVN) {
    const int row = blockIdx.x, t = threadIdx.x, ch0 = t * 8;
    float acc[8];
#pragma unroll
    for (int i = 0; i < 8; ++i) acc[i] = 0.f;
    if (row < NT) {
        const int b = row / L, l = row % L, r = l >> 6, cc = l & 63;
        for (int dr = -1; dr <= 1; ++dr) for (int dc = -1; dc <= 1; ++dc) {
            const int r2 = r + dr, c2 = cc + dc;
            if (r2 < 0 || r2 >= 64 || c2 < 0 || c2 >= 64) continue;
            const u16* src = QKV + (size_t)(b * L + r2 * 64 + c2) * 2048 + ch0;
            const float* w = conv_w + ((dr + 1) * 3 + (dc + 1)) * 2048 + ch0;
#pragma unroll
            for (int i = 0; i < 8; ++i) acc[i] += bf2f(src[i]) * w[i];
        }
    } else {
        const int rr = row - NT, b = rr / CT, tt = rr % CT;
        for (int dc = -1; dc <= 1; ++dc) {
            const int t2 = tt + dc;
            if (t2 < 0 || t2 >= CT) continue;
            const u16* src = QKV + (size_t)(NT + b * CT + t2) * 2048 + ch0;
            const float* w = conv_w + (3 + (dc + 1)) * 2048 + ch0;
#pragma unroll
            for (int i = 0; i < 8; ++i) acc[i] += bf2f(src[i]) * w[i];
        }
    }
    float ss = 0.f;
#pragma unroll
    for (int i = 0; i < 8; ++i) { acc[i] = siluf_(acc[i]); ss += acc[i] * acc[i]; }
    ss += __shfl_xor(ss, 1); ss += __shfl_xor(ss, 2); ss += __shfl_xor(ss, 4); ss += __shfl_xor(ss, 8);
    float sc = 1.f;
    if (t < 64) sc = rsqrtf(ss + EPS) * 0.08838834764831845f;
    else if (t < 128) sc = rsqrtf(ss + EPS);
    u16* dst = QKVN + (size_t)row * 2048 + ch0;
#pragma unroll
    for (int i = 0; i < 8; ++i) dst[i] = f2bf(acc[i] * sc);
}

__global__ __launch_bounds__(128) void k_scan_naive(const u16* __restrict__ QKVN, const float* __restrict__ BA, const float* __restrict__ a_log,
                                                    const float* __restrict__ dt_bias, u16* __restrict__ O) {
    __shared__ float sk[2][128], sq[2][128];
    const int dir = blockIdx.x & 1, hv = (blockIdx.x >> 1) & 7, b = blockIdx.x >> 4, hq = hv >> 1, dv = threadIdx.x;
    const float Aexp = expf(a_log[dir * 8 + hv]), dtb = dt_bias[dir * 8 + hv];
    float S[128];
#pragma unroll
    for (int i = 0; i < 128; ++i) S[i] = 0.f;
    const int nsteps = CT + L;
    auto row_of = [&](int s) -> int {
        if (s < CT) { const int t = dir ? (CT - 1 - s) : s; return NT + b * CT + t; }
        const int l = dir ? (L - 1 - (s - CT)) : (s - CT); return b * L + l;
    };
    { const int row = row_of(0); sk[0][dv] = bf2f(QKVN[(size_t)row * 2048 + 512 + hq * 128 + dv]); sq[0][dv] = bf2f(QKVN[(size_t)row * 2048 + hq * 128 + dv]); }
    __syncthreads();
    for (int s = 0; s < nsteps; ++s) {
        const int cur = s & 1, row = row_of(s);
        if (s + 1 < nsteps) { const int r2 = row_of(s + 1); sk[cur ^ 1][dv] = bf2f(QKVN[(size_t)r2 * 2048 + 512 + hq * 128 + dv]); sq[cur ^ 1][dv] = bf2f(QKVN[(size_t)r2 * 2048 + hq * 128 + dv]); }
        const float v = bf2f(QKVN[(size_t)row * 2048 + 1024 + hv * 128 + dv]);
        const float beta = sigmoidf_(BA[(size_t)row * 32 + dir * 8 + hv]);
        const float gdec = expf(-Aexp * softplusf_(BA[(size_t)row * 32 + 16 + dir * 8 + hv] + dtb));
        float kS = 0.f;
#pragma unroll
        for (int d = 0; d < 128; ++d) kS += sk[cur][d] * S[d];
        const float coef = beta * (v - gdec * kS);
        float o = 0.f;
#pragma unroll
        for (int d = 0; d < 128; ++d) { S[d] = gdec * S[d] + sk[cur][d] * coef; o += sq[cur][d] * S[d]; }
        if (s >= CT) O[((size_t)dir * NT + row) * 1024 + hv * 128 + dv] = f2bf(o);
        __syncthreads();
    }
}

__global__ __launch_bounds__(256) void k_mergeprep(const u16* __restrict__ O, const u16* __restrict__ SZ, const float* __restrict__ gng, u16* __restrict__ OB) {
    const int row = blockIdx.x * 4 + (threadIdx.x >> 6), lane = threadIdx.x & 63;
    const int c0 = lane * 16;
    float o[16]; float ss = 0.f;
#pragma unroll
    for (int i = 0; i < 16; ++i) { o[i] = bf2f(O[(size_t)row * 1024 + c0 + i]) + bf2f(O[((size_t)NT + row) * 1024 + c0 + i]); ss += o[i] * o[i]; }
    ss += __shfl_xor(ss, 1); ss += __shfl_xor(ss, 2); ss += __shfl_xor(ss, 4);
    const float rs = rsqrtf(ss * (1.f / 128.f) + EPS);
#pragma unroll
    for (int i = 0; i < 16; ++i) OB[(size_t)row * 1024 + c0 + i] = f2bf(o[i] * rs * gng[(c0 + i) & 127] * bf2f(SZ[(size_t)row * 1024 + c0 + i]));
}

__global__ __launch_bounds__(256) void k_router(const float* __restrict__ X1, const float* __restrict__ gn2, const float* __restrict__ MOD, const float* __restrict__ w_router,
                                                const float* __restrict__ b_router, u16* __restrict__ H2, int* __restrict__ cnt, int* __restrict__ TOKE, float* __restrict__ WTE,
                                                int* __restrict__ TOPE, int* __restrict__ TOPP) {
    const int row = blockIdx.x * 4 + (threadIdx.x >> 6), lane = threadIdx.x & 63, b = row / L;
    const float* src = X1 + (size_t)row * D;
    float4 v[4]; float ss = 0.f;
#pragma unroll
    for (int j = 0; j < 4; ++j) { v[j] = ((const float4*)src)[lane + 64 * j]; ss += v[j].x * v[j].x + v[j].y * v[j].y + v[j].z * v[j].z + v[j].w * v[j].w; }
    ss = wave_sum(ss);
    const float rstd = rsqrtf(ss * (1.f / D) + EPS);
    const float* sh = MOD + b * 6144 + 3072; const float* sc = MOD + b * 6144 + 4096;
    float lg[32];
#pragma unroll
    for (int e = 0; e < 32; ++e) lg[e] = 0.f;
#pragma unroll
    for (int j = 0; j < 4; ++j) {
        const int k = (lane + 64 * j) * 4;
        const float4 g = *(const float4*)(gn2 + k), s4 = *(const float4*)(sc + k), h4 = *(const float4*)(sh + k);
        float h[4];
        h[0] = v[j].x * rstd * g.x * (1.f + s4.x) + h4.x; h[1] = v[j].y * rstd * g.y * (1.f + s4.y) + h4.y;
        h[2] = v[j].z * rstd * g.z * (1.f + s4.z) + h4.z; h[3] = v[j].w * rstd * g.w * (1.f + s4.w) + h4.w;
        ushort4 o; o.x = f2bf(h[0]); o.y = f2bf(h[1]); o.z = f2bf(h[2]); o.w = f2bf(h[3]);
        *(ushort4*)(H2 + (size_t)row * D + k) = o;
#pragma unroll
        for (int q = 0; q < 4; ++q) {
            const float4* wr = (const float4*)(w_router + (size_t)(k + q) * 32);
#pragma unroll
            for (int e4 = 0; e4 < 8; ++e4) { const float4 w = wr[e4]; lg[e4 * 4] += h[q] * w.x; lg[e4 * 4 + 1] += h[q] * w.y; lg[e4 * 4 + 2] += h[q] * w.z; lg[e4 * 4 + 3] += h[q] * w.w; }
        }
    }
#pragma unroll
    for (int e = 0; e < 32; ++e) lg[e] = wave_sum(lg[e]) + b_router[e];
    int idx[4]; float val[4];
#pragma unroll
    for (int j = 0; j < 4; ++j) {
        float best = -3.0e38f; int bi = 0;
#pragma unroll
        for (int e = 0; e < 32; ++e) { const bool taken = (j > 0 && idx[0] == e) || (j > 1 && idx[1] == e) || (j > 2 && idx[2] == e); if (!taken && lg[e] > best) { best = lg[e]; bi = e; } }
        idx[j] = bi; val[j] = best;
    }
    float w[4], den = 0.f;
#pragma unroll
    for (int j = 0; j < 4; ++j) { w[j] = expf(val[j] - val[0]); den += w[j]; }
    if (lane == 0) {
#pragma unroll
        for (int j = 0; j < 4; ++j) {
            const int e = idx[j]; const int pos = atomicAdd(&cnt[e], 1);
            TOKE[e * CAP + pos] = row; WTE[e * CAP + pos] = w[j] / den; TOPE[row * 4 + j] = e; TOPP[row * 4 + j] = pos;
        }
    }
}

__device__ __forceinline__ int expert_base(const int* cnt, int e) { int b = 0; for (int i = 0; i < e; ++i) b += (cnt[i] + 255) & ~255; return b; }

__global__ __launch_bounds__(256) void k_moe_gu(const u16* __restrict__ H2, const int* __restrict__ cnt, const int* __restrict__ TOKE, const float* __restrict__ w_gate, const float* __restrict__ b_gate,
                                                const float* __restrict__ w_up, const float* __restrict__ b_up, u16* __restrict__ ACT) {
    __shared__ float As[16 * 65], Bs[16 * 65];
    const int e = blockIdx.z, m0 = blockIdx.y * 64, n0 = blockIdx.x * 64, M = cnt[e];
    if (m0 >= M) return;
    const int base = expert_base(cnt, e);
    NG g{}; g.A = H2; g.lda = D; g.gather = TOKE + e * CAP; g.ldb = D; g.M = M; g.N = D; g.K = D;
    float ag[4][4], au[4][4];
    g.B = w_gate + (size_t)e * D * D; ngemm_tile<false>(g, m0, n0, ag, As, Bs);
    g.B = w_up + (size_t)e * D * D; ngemm_tile<false>(g, m0, n0, au, As, Bs);
    const int tx = threadIdx.x & 15, ty = threadIdx.x >> 4;
#pragma unroll
    for (int i = 0; i < 4; ++i)
#pragma unroll
        for (int j = 0; j < 4; ++j) {
            const int m = m0 + ty * 4 + i, n = n0 + tx * 4 + j;
            if (m < M) {
                const float gt = fminf(ag[i][j] + b_gate[e * D + n], 7.f);
                const float up = fminf(fmaxf(au[i][j] + b_up[e * D + n], -7.f), 7.f);
                ACT[(size_t)(base + m) * D + n] = f2bf((up + 1.f) * gt * sigmoidf_(1.702f * gt));
            }
        }
}
__global__ __launch_bounds__(256) void k_moe_down(const u16* __restrict__ ACT, const int* __restrict__ cnt, const float* __restrict__ WTE, const float* __restrict__ w_down, const float* __restrict__ b_down, u16* __restrict__ Y) {
    __shared__ float As[16 * 65], Bs[16 * 65];
    const int e = blockIdx.z, m0 = blockIdx.y * 64, n0 = blockIdx.x * 64, M = cnt[e];
    if (m0 >= M) return;
    const int base = expert_base(cnt, e);
    NG g{}; g.A = ACT + (size_t)base * D; g.lda = D; g.gather = nullptr; g.B = w_down + (size_t)e * D * D; g.ldb = D; g.M = M; g.N = D; g.K = D;
    float acc[4][4];
    ngemm_tile<false>(g, m0, n0, acc, As, Bs);
    const int tx = threadIdx.x & 15, ty = threadIdx.x >> 4;
#pragma unroll
    for (int i = 0; i < 4; ++i)
#pragma unroll
        for (int j = 0; j < 4; ++j) {
            const int m = m0 + ty * 4 + i, n = n0 + tx * 4 + j;
            if (m < M) Y[(size_t)(base + m) * D + n] = f2bf((acc[i][j] + b_down[e * D + n]) * WTE[e * CAP + m]);
        }
}
__global__ __launch_bounds__(256) void k_final(float* __restrict__ out, const u16* __restrict__ Y, const int* __restrict__ cnt, const int* __restrict__ TOPE, const int* __restrict__ TOPP,
                                               const float* __restrict__ MOD, const float* __restrict__ fg) {
    const int row = blockIdx.x * 4 + (threadIdx.x >> 6), lane = threadIdx.x & 63, b = row / L;
    int yrow[4];
#pragma unroll
    for (int j = 0; j < 4; ++j) yrow[j] = expert_base(cnt, TOPE[row * 4 + j]) + TOPP[row * 4 + j];
    float x2[16]; float ss = 0.f;
#pragma unroll
    for (int q = 0; q < 4; ++q) {
        const int k = (lane + 64 * q) * 4;
        const float4 x1 = *(const float4*)(out + (size_t)row * D + k);
        float a[4] = {0.f, 0.f, 0.f, 0.f};
#pragma unroll
        for (int j = 0; j < 4; ++j) { const ushort4 y = *(const ushort4*)(Y + (size_t)yrow[j] * D + k); a[0] += bf2f(y.x); a[1] += bf2f(y.y); a[2] += bf2f(y.z); a[3] += bf2f(y.w); }
        const float4 g2 = *(const float4*)(MOD + b * 6144 + 5120 + k);
        x2[q * 4 + 0] = x1.x + g2.x * a[0]; x2[q * 4 + 1] = x1.y + g2.y * a[1]; x2[q * 4 + 2] = x1.z + g2.z * a[2]; x2[q * 4 + 3] = x1.w + g2.w * a[3];
#pragma unroll
        for (int i = 0; i < 4; ++i) ss += x2[q * 4 + i] * x2[q * 4 + i];
    }
    ss = wave_sum(ss);
    const float rstd = rsqrtf(ss * (1.f / D) + EPS);
#pragma unroll
    for (int q = 0; q < 4; ++q) {
        const int k = (lane + 64 * q) * 4;
        const float4 g = *(const float4*)(fg + k);
        float4 o; o.x = x2[q * 4] * rstd * g.x; o.y = x2[q * 4 + 1] * rstd * g.y; o.z = x2[q * 4 + 2] * rstd * g.z; o.w = x2[q * 4 + 3] * rstd * g.w;
        *(float4*)(out + (size_t)row * D + k) = o;
    }
}

extern "C" void kernel_launch(void* const* d_in, const int* in_sizes, int n_in, void* d_out, int out_size, void* d_ws, size_t ws_size, hipStream_t stream) {
    if (n_in != 25 || ws_size < WS_NEED || out_size != NT * D) { fprintf(stderr, "kernel_launch: unexpected sizes n_in %d ws %zu (need %zu) out %d\n", n_in, ws_size, (size_t)WS_NEED, out_size); return; }
    const float* x = (const float*)d_in[0]; const float* c = (const float*)d_in[1]; const float* ctx = (const float*)d_in[2]; const float* c_ctx = (const float*)d_in[3];
    const float* w_mod = (const float*)d_in[4]; const float* b_mod = (const float*)d_in[5]; const float* norm1_g = (const float*)d_in[6]; const float* norm2_g = (const float*)d_in[7];
    const float* w_in = (const float*)d_in[8]; const float* conv_w = (const float*)d_in[9]; const float* a_log = (const float*)d_in[10]; const float* dt_bias = (const float*)d_in[11];
    const float* gdn_norm_g = (const float*)d_in[12]; const float* w_fo = (const float*)d_in[13]; const float* w_go = (const float*)d_in[14]; const float* w_mo = (const float*)d_in[15];
    const float* w_router = (const float*)d_in[16]; const float* b_router = (const float*)d_in[17]; const float* w_gate = (const float*)d_in[18]; const float* b_gate = (const float*)d_in[19];
    const float* w_up = (const float*)d_in[20]; const float* b_up = (const float*)d_in[21]; const float* w_down = (const float*)d_in[22]; const float* b_down = (const float*)d_in[23];
    const float* final_g = (const float*)d_in[24];
    char* ws = (char*)d_ws; float* out = (float*)d_out;
    int* cnt = (int*)(ws + WS_CTL); float* MOD = (float*)(ws + WS_MOD); int* TOPE = (int*)(ws + WS_TOPE); int* TOPP = (int*)(ws + WS_TOPP);
    int* TOKE = (int*)(ws + WS_TOKE); float* WTE = (float*)(ws + WS_WTE); u16* H2 = (u16*)(ws + WS_H2);
    u16* U = (u16*)(ws + WS_U); u16* OB = (u16*)(ws + WS_OB); u16* QKV = (u16*)(ws + WS_QKV); u16* T1 = (u16*)(ws + WS_T1); float* BA = (float*)(ws + WS_BA);
    u16* SZ = (u16*)(ws + WS_SZ); u16* GA = (u16*)(ws + WS_GA); u16* GB = (u16*)(ws + WS_GB); u16* FB = (u16*)(ws + WS_FB); u16* FT2 = (u16*)(ws + WS_FT2);
    u16* DFTM = (u16*)(ws + WS_DFTM); u16* O = (u16*)(ws + WS_O); u16* FM = (u16*)(ws + WS_FM); u16* QKVN = (u16*)(ws + WS_QKVN); u16* M1 = (u16*)(ws + WS_M1);
    u16* ACT = (u16*)(ws + WS_ACT); u16* Y = (u16*)(ws + WS_Y);

    (void)hipMemsetAsync(ws + WS_CTL, 0, 1 * MiB, stream);
    k_mod<<<24, 256, 0, stream>>>(c, c_ctx, w_mod, b_mod, MOD);
    k_u<<<MR / 4, 256, 0, stream>>>(x, ctx, norm1_g, MOD, U);
    k_dftm<<<4096, 256, 0, stream>>>(DFTM);
    { NG g{U, D, nullptr, w_in, IN_COLS, MR, IN_COLS, D, 0}; EpiIn e{QKV, SZ, FB, GA, GB, BA};
      k_ngemm<false, EpiIn><<<dim3((IN_COLS + 63) / 64, MR / 64, 1), 256, 0, stream>>>(g, e, 0, 0); }
    k_chandft<<<dim3(NT / 64, 4), 256, 0, stream>>>(FB, FT2);
    { NG g{DFTM, 8192, nullptr, FT2, 8192, 4096, 512, 8192, 0}; EpiFM e{FM, 1.f / 724.0773439350247f, 0};
      k_ngemm<true, EpiFM><<<dim3(8, 64, 4), 256, 0, stream>>>(g, e, (long)512 * 8192, 4096); }
    k_conv<<<MR, 256, 0, stream>>>(QKV, conv_w, QKVN);
    k_scan_naive<<<64, 128, 0, stream>>>(QKVN, BA, a_log, dt_bias, O);
    k_mergeprep<<<NT / 4, 256, 0, stream>>>(O, SZ, gdn_norm_g, OB);
    { NG g{FM, 512, nullptr, w_fo, D, NT, D, 512, 0}; EpiT1 e{T1, GA};
      k_ngemm<false, EpiT1><<<dim3(16, NT / 64, 1), 256, 0, stream>>>(g, e, 0, 0); }
    { NG g{OB, D, nullptr, w_go, D, NT, D, D, 0}; EpiM1 e{M1, T1, GB};
      k_ngemm<false, EpiM1><<<dim3(16, NT / 64, 1), 256, 0, stream>>>(g, e, 0, 0); }
    { NG g{M1, D, nullptr, w_mo, D, NT, D, D, 0}; EpiX1 e{out, x, MOD};
      k_ngemm<false, EpiX1><<<dim3(16, NT / 64, 1), 256, 0, stream>>>(g, e, 0, 0); }
    k_router<<<NT / 4, 256, 0, stream>>>(out, norm2_g, MOD, w_router, b_router, H2, cnt, TOKE, WTE, TOPE, TOPP);
    k_moe_gu<<<dim3(16, CAP / 64, NE), 256, 0, stream>>>(H2, cnt, TOKE, w_gate, b_gate, w_up, b_up, ACT);
    k_moe_down<<<dim3(16, CAP / 64, NE), 256, 0, stream>>>(ACT, cnt, WTE, w_down, b_down, Y);
    k_final<<<NT / 4, 256, 0, stream>>>(out, Y, cnt, TOPE, TOPP, MOD, final_g);
}
```

```cpp
#include <hip/hip_runtime.h>
#include <hip/hip_cooperative_groups.h>
#include <cstdio>
#include <cstdint>

typedef unsigned short u16;

constexpr int D = 1024, NB = 4, L = 4096, NT = NB * L, CT = 256, NC = NB * CT, MR = NT + NC;
constexpr int IN_COLS = 5664;
constexpr int NE = 32, CAP = 16384, SLOTS = 73728;
constexpr float EPS = 1e-6f;

constexpr size_t MiB = 1u << 20;
constexpr size_t WS_CTL = 0;
constexpr size_t WS_MOD = 1 * MiB;
constexpr size_t WS_TOPE = 2 * MiB;
constexpr size_t WS_TOPP = 3 * MiB;
constexpr size_t WS_TOKE = 4 * MiB;
constexpr size_t WS_WTE = 6 * MiB;
constexpr size_t WS_H2 = 8 * MiB;
constexpr size_t WS_B = 40 * MiB;
constexpr size_t WS_U = WS_B;
constexpr size_t WS_OB = WS_U;
constexpr size_t WS_QKV = WS_U + 34 * MiB;
constexpr size_t WS_T1 = WS_QKV;
constexpr size_t WS_BA = WS_QKV + 68 * MiB;
constexpr size_t WS_SZ = WS_BA + 3 * MiB;
constexpr size_t WS_GA = WS_SZ + 32 * MiB;
constexpr size_t WS_GB = WS_GA + 32 * MiB;
constexpr size_t WS_FB = WS_GB + 32 * MiB;
constexpr size_t WS_FT2 = WS_FB + 16 * MiB;
constexpr size_t WS_DFTM = WS_FT2 + 32 * MiB;
constexpr size_t WS_O = WS_DFTM;
constexpr size_t WS_FM = WS_DFTM + 64 * MiB;
constexpr size_t WS_QKVN = WS_FM + 16 * MiB;
constexpr size_t WS_M1 = WS_QKVN;
constexpr size_t WS_END_B = WS_QKVN + 68 * MiB;
constexpr size_t WS_ACT = WS_B;
constexpr size_t WS_Y = WS_B + 144 * MiB;
constexpr size_t WS_NEED = (WS_END_B > WS_Y + 144 * MiB) ? WS_END_B : (WS_Y + 144 * MiB);

__device__ __forceinline__ float bf2f(u16 v) { return __uint_as_float(((unsigned)v) << 16); }
__device__ __forceinline__ u16 f2bf(float f) { unsigned u = __float_as_uint(f); u += 0x7fffu + ((u >> 16) & 1u); return (u16)(u >> 16); }
__device__ __forceinline__ float sigmoidf_(float v) { return 1.f / (1.f + expf(-v)); }
__device__ __forceinline__ float siluf_(float v) { return v / (1.f + expf(-v)); }
__device__ __forceinline__ float softplusf_(float v) { return v > 20.f ? v : log1pf(expf(v)); }
__device__ __forceinline__ float wave_sum(float v) {
#pragma unroll
    for (int o = 1; o < 64; o <<= 1) v += __shfl_xor(v, o);
    return v;
}

namespace cg = cooperative_groups;
#define DI __device__ __forceinline__
constexpr size_t WS_FT2N = 458 * MiB;
constexpr size_t FE_OUT_OFF = 48 * MiB;
constexpr size_t WS_NYQ = 506 * MiB;
constexpr size_t WS_FM2 = 8 * MiB;
constexpr size_t WS_IMGH = 24 * MiB;
constexpr size_t WS_O2 = 74 * MiB;
constexpr size_t WS_IMGHD = 241 * MiB;
constexpr int IMGH_STRIDE = 35840, IMGHD_STRIDE = 44032;
constexpr int IH_Q = 0, IH_KT = 17408;
constexpr int ID_W = 0, ID_QK = 17408, ID_G = 26624, ID_UT = 27648;
static_assert(WS_IMGH + (size_t)1088 * IMGH_STRIDE <= 62 * MiB && WS_IMGHD + (size_t)4352 * IMGHD_STRIDE <= 424 * MiB, "gdn images");

struct Ctx {
    const float *x, *c, *ctx, *c_ctx, *w_mod, *b_mod, *norm1_g, *norm2_g, *w_in, *conv_w, *a_log, *dt_bias, *gdn_norm_g, *w_fo, *w_go, *w_mo,
                *w_router, *b_router, *w_gate, *b_gate, *w_up, *b_up, *w_down, *b_down, *final_g;
    float* out; char* ws;
};
struct Blk { int G, bid, tid, wave, lane; };
DI Blk mkblk(int wv) { int g = gridDim.x, bi = blockIdx.x; asm volatile("" : "+s"(wv), "+s"(g), "+s"(bi)); Blk B; B.G = g; B.bid = bi; B.wave = wv;
    int ln; asm volatile("v_mbcnt_lo_u32_b32 %0, -1, 0\n\tv_mbcnt_hi_u32_b32 %0, -1, %0" : "=v"(ln)); B.lane = ln; B.tid = wv * 64 + ln; return B; }
DI const Ctx& ctx() { const __attribute__((address_space(4))) char* p = (const __attribute__((address_space(4))) char*)__builtin_amdgcn_kernarg_segment_ptr(); asm volatile("" : "+s"(p)); return *(const Ctx*)(const char*)p; }

constexpr int MOD_FLAG = 2304;
DI void ph_mod(const Ctx& c, const Blk& B, float* lds) {
    float* s = lds;
    float* part = lds + 5 * 1024;
    float* MOD = (float*)(c.ws + WS_MOD);
    for (int i = B.tid; i < 5 * 1024; i += 512) { const int r = i >> 10, k = i & 1023; const float v = r < 4 ? c.c[r * 1024 + k] : c.c_ctx[k]; s[i] = siluf_(v); }
    __syncthreads();
    for (int item = B.bid; item < 96; item += B.G) {
        const int n = item * 64 + B.lane;
        float a0 = 0.f, a1 = 0.f, a2 = 0.f, a3 = 0.f, a4 = 0.f;
        const int k0 = B.wave * 128;
#pragma unroll 32
        for (int k = k0; k < k0 + 128; ++k) { const float w = c.w_mod[(size_t)k * 6144 + n]; a0 += s[k] * w; a1 += s[1024 + k] * w; a2 += s[2048 + k] * w; a3 += s[3072 + k] * w; a4 += s[4096 + k] * w; }
        float* p = part + B.wave * 320 + B.lane;
        p[0] = a0; p[64] = a1; p[128] = a2; p[192] = a3; p[256] = a4;
        __syncthreads();
        if (B.tid < 320) { const int r = B.tid >> 6, l = B.tid & 63; float t = 0.f;
#pragma unroll
            for (int w = 0; w < 8; ++w) t += part[w * 320 + r * 64 + l];
            MOD[r * 6144 + item * 64 + l] = t + c.b_mod[item * 64 + l]; }
        asm volatile("s_waitcnt vmcnt(0)" ::: "memory");
        __syncthreads();
        if (B.tid == 0) { __builtin_amdgcn_fence(__ATOMIC_RELEASE, "agent"); __hip_atomic_fetch_add((unsigned*)c.ws + MOD_FLAG, 1u, __ATOMIC_RELEASE, __HIP_MEMORY_SCOPE_AGENT); }
    }
}
DI void wait_mod(const Ctx& c, const Blk& B) {
    if (B.tid == 0) {
        while (__hip_atomic_load((unsigned*)c.ws + MOD_FLAG, __ATOMIC_RELAXED, __HIP_MEMORY_SCOPE_AGENT) < 96u) __builtin_amdgcn_s_sleep(2);
        __builtin_amdgcn_fence(__ATOMIC_ACQUIRE, "agent");
    }
    __syncthreads();
}
DI void u_row(const Ctx& c, const float* MOD, const float* src, int mr, int lane, float (&y)[16]) {
    float4 v[4]; float ss = 0.f;
#pragma unroll
    for (int j = 0; j < 4; ++j) { v[j] = ((const float4*)src)[lane + 64 * j]; ss += v[j].x * v[j].x + v[j].y * v[j].y + v[j].z * v[j].z + v[j].w * v[j].w; }
    ss = wave_sum(ss);
    const float rstd = rsqrtf(ss * (1.f / D) + EPS);
    const float* sh = MOD + mr * 6144; const float* sc = sh + 1024;
#pragma unroll
    for (int j = 0; j < 4; ++j) {
        const int k = (lane + 64 * j) * 4;
        const float4 g = *(const float4*)(c.norm1_g + k), s4 = *(const float4*)(sc + k), h4 = *(const float4*)(sh + k);
        y[4 * j] = v[j].x * rstd * g.x * (1.f + s4.x) + h4.x; y[4 * j + 1] = v[j].y * rstd * g.y * (1.f + s4.y) + h4.y;
        y[4 * j + 2] = v[j].z * rstd * g.z * (1.f + s4.z) + h4.z; y[4 * j + 3] = v[j].w * rstd * g.w * (1.f + s4.w) + h4.w;
    }
}
DI void u_store(u16* dst, int lane, const float (&y)[16]) {
#pragma unroll
    for (int j = 0; j < 4; ++j) { ushort4 o4; o4.x = f2bf(y[4 * j]); o4.y = f2bf(y[4 * j + 1]); o4.z = f2bf(y[4 * j + 2]); o4.w = f2bf(y[4 * j + 3]); *(ushort4*)(dst + (lane + 64 * j) * 4) = o4; }
}
DI void ph_u(const Ctx& c, const Blk& B) {
    const float* MOD = (const float*)(c.ws + WS_MOD); u16* U = (u16*)(c.ws + WS_U); u16* UE = (u16*)(c.ws + WS_FT2N); u16* UO = UE + (size_t)8192 * 1024;
    for (int task = B.bid * 8 + B.wave; task < 4 * 2049 + NC; task += B.G * 8) {
        float ya[16];
        if (task >= 4 * 2049) { const int row = NT + task - 4 * 2049; u_row(c, MOD, c.ctx + (size_t)(row - NT) * D, 4, B.lane, ya); u_store(U + (size_t)row * D, B.lane, ya); continue; }
        const int b = task / 2049, l = task % 2049, rowA = b * L + l;
        u_row(c, MOD, c.x + (size_t)rowA * D, b, B.lane, ya); u_store(U + (size_t)rowA * D, B.lane, ya);
        if (l == 2048) { u_store((u16*)(c.ws + WS_NYQ + 16384) + (size_t)b * D, B.lane, ya); continue; }
        float e[16], o[16];
        if (l >= 1) {
            float yb[16]; const int rowB = b * L + (L - l);
            u_row(c, MOD, c.x + (size_t)rowB * D, b, B.lane, yb); u_store(U + (size_t)rowB * D, B.lane, yb);
#pragma unroll
            for (int i = 0; i < 16; ++i) { e[i] = ya[i] + yb[i]; o[i] = ya[i] - yb[i]; }
        } else {
#pragma unroll
            for (int i = 0; i < 16; ++i) { e[i] = ya[i]; o[i] = 0.f; }
        }
        u_store(UE + (size_t)(b * 2048 + l) * D, B.lane, e); u_store(UO + (size_t)(b * 2048 + l) * D, B.lane, o);
    }
}

DI void moe_tables(const Ctx& c, const Blk& B, int* tab) {
    const int* cnt = (const int*)(c.ws + WS_CTL);
    __syncthreads();
    if (B.tid == 0) { int ts = 0, sb = 0; for (int e = 0; e < 32; ++e) { const int n = cnt[64 * e]; tab[e] = ts; tab[40 + e] = sb; tab[80 + e] = n; ts += ((n + 63) / 64) * 16; sb += (n + 255) & ~255; } tab[32] = ts; tab[72] = sb; }
    __syncthreads();
}
DI void ph_final(const Ctx& c, const Blk& B, float* lds) {
    int* tab = (int*)lds;
    moe_tables(c, B, tab);
    const u16* Y = (const u16*)(c.ws + WS_Y); const int* TOPE = (const int*)(c.ws + WS_TOPE); const int* TOPP = (const int*)(c.ws + WS_TOPP); const float* MOD = (const float*)(c.ws + WS_MOD);
    float* out = c.out;
    for (int row = B.bid * 8 + B.wave; row < NT; row += B.G * 8) {
        const int b = row / L;
        int yrow[4];
#pragma unroll
        for (int j = 0; j < 4; ++j) yrow[j] = tab[40 + TOPE[row * 4 + j]] + TOPP[row * 4 + j];
        float x2[16]; float ss = 0.f;
#pragma unroll
        for (int q = 0; q < 4; ++q) {
            const int k = (B.lane + 64 * q) * 4;
            const float4 x1 = *(const float4*)(out + (size_t)row * D + k);
            float a[4] = {0.f, 0.f, 0.f, 0.f};
#pragma unroll
            for (int j = 0; j < 4; ++j) { const ushort4 y = *(const ushort4*)(Y + (size_t)yrow[j] * D + k); a[0] += bf2f(y.x); a[1] += bf2f(y.y); a[2] += bf2f(y.z); a[3] += bf2f(y.w); }
            const float4 g2 = *(const float4*)(MOD + b * 6144 + 5120 + k);
            x2[q * 4 + 0] = x1.x + g2.x * a[0]; x2[q * 4 + 1] = x1.y + g2.y * a[1]; x2[q * 4 + 2] = x1.z + g2.z * a[2]; x2[q * 4 + 3] = x1.w + g2.w * a[3];
#pragma unroll
            for (int i = 0; i < 4; ++i) ss += x2[q * 4 + i] * x2[q * 4 + i];
        }
        ss = wave_sum(ss);
        const float rstd = rsqrtf(ss * (1.f / D) + EPS);
#pragma unroll
        for (int q = 0; q < 4; ++q) {
            const int k = (B.lane + 64 * q) * 4;
            const float4 g = *(const float4*)(c.final_g + k);
            float4 o; o.x = x2[q * 4] * rstd * g.x; o.y = x2[q * 4 + 1] * rstd * g.y; o.z = x2[q * 4 + 2] * rstd * g.z; o.w = x2[q * 4 + 3] * rstd * g.w;
            *(float4*)(out + (size_t)row * D + k) = o;
        }
    }
}

namespace pg {
#define LAS __attribute__((address_space(3)))
typedef short bf16x8 __attribute__((ext_vector_type(8)));
typedef float f32x4 __attribute__((ext_vector_type(4)));
typedef unsigned u32x4 __attribute__((ext_vector_type(4)));
typedef unsigned u32x2 __attribute__((ext_vector_type(2)));
constexpr int HTB = 128 * 64 * 2;
DI int lds_byte(int r, int c) { const int st = (r >> 4) * 2 + (c >> 5), rr = r & 15, cc = c & 31, ob = rr * 64 + cc * 2; return st * 1024 + (ob ^ (((ob >> 9) & 1) << 5)); }
DI void stage_rc(int b, int& R, int& C) { const int st = b / 1024, sb = b % 1024, swz = sb ^ (((sb >> 9) & 1) << 5); R = (st >> 1) * 16 + swz / 64; C = (st & 1) * 32 + (swz % 64) / 2; }
DI int perm32(int rho) { const int n = rho >> 4, i = rho & 15; return 8 * (i >> 2) + 4 * n + (i & 3); }
typedef float f32x2_ __attribute__((ext_vector_type(2)));
typedef __bf16 bf16x2_ __attribute__((ext_vector_type(2)));
DI unsigned cvt_pk_bf16(float lo, float hi) { const f32x2_ v = {lo, hi}; return __builtin_bit_cast(unsigned, __builtin_convertvector(v, bf16x2_)); }

struct Unit {
    const char *a0, *a1;
    const char *b0, *b1;
    unsigned v00, v01, v10, v11;
    int nt;
    int kind, pm, pn, ex;
};
DI void lane_rc(int tid, int i, int& R, int& C) { stage_rc(tid * 16 + i * 8192, R, C); }

template <bool PERM, bool GATHER, class Sched, class Epi>
DI void gemm_phase(LAS unsigned char* lds, int tid_in, int lda_elems, int ldb_elems, const Sched& S, const Epi& E) {
    const int tid = tid_in, wid = __builtin_amdgcn_readfirstlane(tid >> 6), lane = tid & 63, wr = wid >> 2, wc = wid & 3, fr = lane & 15, fq = lane >> 4;
    unsigned voffB0, voffB1, voffA0, voffA1;
    { int R, C; lane_rc(tid, 0, R, C); const int Rb = PERM ? ((R & ~31) + perm32(R & 31)) : R; voffB0 = (unsigned)(Rb * ldb_elems + C) * 2u; voffA0 = (unsigned)(R * lda_elems + C) * 2u; }
    { int R, C; lane_rc(tid, 1, R, C); const int Rb = PERM ? ((R & ~31) + perm32(R & 31)) : R; voffB1 = (unsigned)(Rb * ldb_elems + C) * 2u; voffA1 = (unsigned)(R * lda_elems + C) * 2u; }
#define VA0(u, h) (GATHER ? ((h) ? (u).v10 : (u).v00) : voffA0)
#define VA1(u, h) (GATHER ? ((h) ? (u).v11 : (u).v01) : voffA1)
    const unsigned ldsw = (unsigned)wid * 1024u;
    const int aoff = lds_byte(wr * 64 + fr, fq * 8), boff = lds_byte(wc * 32 + fr, fq * 8);
#define PG_SA(b, h) (((b) * 2 + (h)) * HTB)
#define PG_SB(b, h) ((4 + (b) * 2 + (h)) * HTB)
#define PG_STAGE2(bufoff, gbase, o0, o1) do { \
        __builtin_amdgcn_global_load_lds((const unsigned*)((const char*)(gbase) + (o0)), (LAS unsigned*)(lds + (bufoff) + ldsw), 16, 0, 0); \
        __builtin_amdgcn_global_load_lds((const unsigned*)((const char*)(gbase) + (o1)), (LAS unsigned*)(lds + (bufoff) + ldsw + 8192), 16, 0, 0); } while (0)
#define PG_STAGEB(bufoff, gbase) PG_STAGE2(bufoff, gbase, voffB0, voffB1)
#define PG_LDA(dst, b, h) do { _Pragma("unroll") for (int m = 0; m < 4; ++m) _Pragma("unroll") for (int k = 0; k < 2; ++k) dst[m][k] = *(const LAS bf16x8*)(lds + PG_SA(b, h) + aoff + m * 2048 + k * 1024); } while (0)
#define PG_LDB(dst, b, h) do { _Pragma("unroll") for (int n = 0; n < 2; ++n) _Pragma("unroll") for (int k = 0; k < 2; ++k) dst[n][k] = *(const LAS bf16x8*)(lds + PG_SB(b, h) + boff + n * 2048 + k * 1024); } while (0)
#define PG_MMA(ai, bj, At, Bt) do { __builtin_amdgcn_s_setprio(1); _Pragma("unroll") for (int m = 0; m < 4; ++m) _Pragma("unroll") for (int n = 0; n < 2; ++n) _Pragma("unroll") for (int k = 0; k < 2; ++k) \
        acc[ai][bj][m][n] = __builtin_amdgcn_mfma_f32_16x16x32_bf16(Bt[n][k], At[m][k], acc[ai][bj][m][n], 0, 0, 0); __builtin_amdgcn_s_setprio(0); } while (0)
#define PG_WAIT_V(n) asm volatile("s_waitcnt vmcnt(" #n ")" ::: "memory")
#define PG_WAIT_L(n) asm volatile("s_waitcnt lgkmcnt(" #n ")" ::: "memory")
#define PG_BAR __builtin_amdgcn_s_barrier()
#define PG_SCHED __builtin_amdgcn_sched_barrier(0)
    Unit cur, nxt; int ui = 0;
    if (!S.next(0, cur)) return;
    f32x4 acc[2][2][4][2];
#pragma unroll
    for (int a = 0; a < 2; ++a)
#pragma unroll
        for (int b = 0; b < 2; ++b)
#pragma unroll
            for (int m = 0; m < 4; ++m)
#pragma unroll
                for (int n = 0; n < 2; ++n) acc[a][b][m][n] = (f32x4){0.f, 0.f, 0.f, 0.f};
    bf16x8 At[4][2], B0[2][2], B1[2][2];
    PG_STAGEB(PG_SB(0, 0), cur.b0); PG_STAGEB(PG_SB(0, 1), cur.b1); PG_STAGE2(PG_SA(0, 0), cur.a0, VA0(cur, 0), VA1(cur, 0)); PG_STAGE2(PG_SA(0, 1), cur.a1, VA0(cur, 1), VA1(cur, 1));
    if (wr == 1) PG_BAR;
    PG_WAIT_V(2); PG_BAR;
    PG_STAGEB(PG_SB(1, 0), cur.b0 + 128); PG_STAGE2(PG_SA(1, 0), cur.a0 + 128, VA0(cur, 0), VA1(cur, 0)); PG_STAGEB(PG_SB(1, 1), cur.b1 + 128);
    PG_WAIT_V(6); PG_BAR;
    for (;;) {
        const bool has_next = S.next(ui + 1, nxt);
        if (!has_next) nxt = cur;
        const int nt = cur.nt;
        for (int t = 0; t < nt; t += 2) {
            const bool last = (t == nt - 2);
            const size_t o1 = (size_t)(t + 1) * 128, o2 = last ? 0 : (size_t)(t + 2) * 128;
            const char* a20 = (last ? nxt.a0 : cur.a0) + o2; const char* a21 = (last ? nxt.a1 : cur.a1) + o2;
            const char* b20 = (last ? nxt.b0 : cur.b0) + o2; const char* b21 = (last ? nxt.b1 : cur.b1) + o2;
            unsigned w00, w01, w10, w11;
            if (GATHER) { w00 = last ? nxt.v00 : cur.v00; w01 = last ? nxt.v01 : cur.v01; w10 = last ? nxt.v10 : cur.v10; w11 = last ? nxt.v11 : cur.v11; }
            else { w00 = voffA0; w01 = voffA1; w10 = voffA0; w11 = voffA1; }
            PG_LDB(B0, 0, 0); PG_LDB(B1, 0, 1); PG_SCHED; PG_LDA(At, 0, 0); PG_STAGE2(PG_SA(1, 1), cur.a1 + o1, VA0(cur, 1), VA1(cur, 1));
            PG_WAIT_V(8); PG_WAIT_L(0); PG_BAR; PG_MMA(0, 0, At, B0); PG_MMA(0, 1, At, B1); PG_BAR; PG_SCHED;
            PG_LDA(At, 0, 1); PG_STAGEB(PG_SB(0, 0), b20); PG_STAGEB(PG_SB(0, 1), b21); PG_STAGE2(PG_SA(0, 0), a20, w00, w01);
            PG_WAIT_V(8); PG_WAIT_L(0); PG_BAR; PG_MMA(1, 0, At, B0); PG_MMA(1, 1, At, B1); PG_BAR; PG_SCHED;
            PG_LDB(B0, 1, 0); PG_LDB(B1, 1, 1); PG_SCHED; PG_LDA(At, 1, 0); PG_STAGE2(PG_SA(0, 1), a21, w10, w11);
            PG_WAIT_V(8); PG_WAIT_L(0); PG_BAR; PG_MMA(0, 0, At, B0); PG_MMA(0, 1, At, B1); PG_BAR; PG_SCHED;
            PG_LDA(At, 1, 1); PG_STAGEB(PG_SB(1, 0), b20 + 128); PG_STAGEB(PG_SB(1, 1), b21 + 128); PG_STAGE2(PG_SA(1, 0), a20 + 128, w00, w01);
            PG_WAIT_V(8); PG_WAIT_L(0); PG_BAR; PG_MMA(1, 0, At, B0); PG_MMA(1, 1, At, B1); PG_BAR; PG_SCHED;
        }
        if (wr == 0) PG_BAR;
        E(acc, cur, wr, wc, fr, fq);
        if (!has_next) break;
#pragma unroll
        for (int a = 0; a < 2; ++a)
#pragma unroll
            for (int b = 0; b < 2; ++b)
#pragma unroll
                for (int m = 0; m < 4; ++m)
#pragma unroll
                    for (int n = 0; n < 2; ++n) acc[a][b][m][n] = (f32x4){0.f, 0.f, 0.f, 0.f};
        cur = nxt; ++ui;
        if (wr == 1) PG_BAR;
    }
    PG_WAIT_V(0);
    PG_BAR;
#undef VA0
#undef VA1
#undef PG_SA
#undef PG_SB
#undef PG_STAGE2
#undef PG_STAGEB
#undef PG_LDA
#undef PG_LDB
#undef PG_MMA
#undef PG_WAIT_V
#undef PG_WAIT_L
#undef PG_BAR
#undef PG_SCHED
}
}

constexpr size_t WS_SSP = 402 * MiB;
constexpr size_t WS_WINT = 440 * MiB;
constexpr size_t WS_WFT = WS_WINT + 11 * MiB;
constexpr size_t WS_WFOT = WS_WFT + 2 * MiB;
constexpr size_t WS_WGOT = WS_WFOT + 1 * MiB;
constexpr size_t WS_WMOT = WS_WGOT + 2 * MiB;
constexpr size_t WS_WGT = WS_B + 144 * MiB;
constexpr size_t WS_WUT = WS_WGT + 64 * MiB;
constexpr size_t WS_WDT = WS_WUT + 64 * MiB + 16 * MiB;
static_assert(WS_WMOT + 2 * MiB <= 512 * MiB && WS_WDT + 64 * MiB <= WS_WINT, "ws map");

DI unsigned pk2(float lo, float hi) { return (unsigned)f2bf(lo) | ((unsigned)f2bf(hi) << 16); }
DI void transpose_item(const float* src, int ldw, u16* WT, int K, int k0, int dst_row, float* scr, int lane, bool zero) {
    if (!zero) {
#pragma unroll 8
        for (int i = 0; i < 32; ++i) { const int kk = 2 * i + (lane >> 5); scr[kk * 33 + (lane & 31)] = src[(size_t)(k0 + kk) * ldw + (lane & 31)]; }
    }
    asm volatile("s_waitcnt lgkmcnt(0)" ::: "memory");
    const int cc = lane & 7;
#pragma unroll
    for (int j = 0; j < 4; ++j) { const int n = (lane >> 3) + 8 * j; const float* s = scr + (8 * cc) * 33 + n;
        uint4 o;
        if (zero) o = make_uint4(0u, 0u, 0u, 0u);
        else { o.x = pk2(s[0 * 33], s[1 * 33]); o.y = pk2(s[2 * 33], s[3 * 33]); o.z = pk2(s[4 * 33], s[5 * 33]); o.w = pk2(s[6 * 33], s[7 * 33]); }
        *(uint4*)(WT + (size_t)(dst_row + n) * K + k0 + 8 * cc) = o; }
    asm volatile("s_waitcnt lgkmcnt(0)" ::: "memory");
}
DI void ph_wprep_small(const Ctx& c, const Blk& B, float* lds) {
    float* scr = lds + B.wave * 2176;
    u16* WINT = (u16*)(c.ws + WS_WINT); u16* WFOT = (u16*)(c.ws + WS_WFOT); u16* WGOT = (u16*)(c.ws + WS_WGOT); u16* WMOT = (u16*)(c.ws + WS_WMOT);
    constexpr int I_IN = 168 * 16, I_FO = 32 * 8, I_GO = 32 * 16, I_MO = 32 * 16;
    int* slot = (int*)(lds + 8 * 2176);
    unsigned* ctr = (unsigned*)c.ws + 2176;
    for (;;) {
        __syncthreads();
        if (B.tid == 0) *slot = (int)__hip_atomic_fetch_add(ctr, 1u, __ATOMIC_RELAXED, __HIP_MEMORY_SCOPE_AGENT);
        __syncthreads();
        const int it = *slot * 8 + B.wave;
        if (*slot * 8 >= I_IN + I_FO + I_GO + I_MO) break;
        if (it >= I_IN + I_FO + I_GO + I_MO) continue;
        int r = it;
        if (r < I_IN) { const int nb = r >> 4, kb = r & 15, n0 = nb * 32;
            int sc; bool zero = false;
            if (n0 < 2048) sc = n0; else if (n0 < 3072) sc = 2080 + (n0 - 2048); else if (n0 < 4096) sc = 3616 + (n0 - 3072); else if (n0 < 5120) sc = 4640 + (n0 - 4096); else if (n0 < 5152) sc = 2048; else { sc = 0; zero = true; }
            transpose_item(c.w_in + sc, IN_COLS, WINT, 1024, kb * 64, n0, scr, B.lane, zero); continue; }
        r -= I_IN;
        if (r < I_FO) { const int nb = r >> 3, kb = r & 7; transpose_item(c.w_fo + nb * 32, 1024, WFOT, 512, kb * 64, nb * 32, scr, B.lane, false); continue; }
        r -= I_FO;
        if (r < I_GO) { const int nb = r >> 4, kb = r & 15; transpose_item(c.w_go + nb * 32, 1024, WGOT, 1024, kb * 64, nb * 32, scr, B.lane, false); continue; }
        r -= I_GO;
        { const int nb = r >> 4, kb = r & 15; transpose_item(c.w_mo + nb * 32, 1024, WMOT, 1024, kb * 64, nb * 32, scr, B.lane, false); }
    }
}
DI size_t early_off(int m) { return m < 14 ? ((size_t)424 * MiB + (size_t)m * 2 * MiB) : m < 38 ? ((size_t)458 * MiB + (size_t)(m - 14) * 2 * MiB) : ((size_t)507 * MiB + (size_t)(m - 38) * 2 * MiB); }
DI size_t gate_off(int e) { return early_off(e); }
DI size_t up_off(int e) { return e < 8 ? early_off(32 + e) : (WS_WUT + (size_t)e * 2 * MiB); }
constexpr int N_EARLY = 40;
DI void transpose64(const float* W, u16* WT, float* scr, int lane) {
    pg::f32x4 v[16];
#pragma unroll
    for (int t = 0; t < 16; ++t) v[t] = *(const pg::f32x4*)(W + (size_t)(4 * t + (lane >> 4)) * D + (lane & 15) * 4);
#pragma unroll
    for (int t = 0; t < 16; ++t) { float* d = scr + (4 * t + (lane >> 4)) * 65 + (lane & 15) * 4; d[0] = v[t][0]; d[1] = v[t][1]; d[2] = v[t][2]; d[3] = v[t][3]; }
    asm volatile("s_waitcnt lgkmcnt(0)" ::: "memory");
    const int cc = lane & 7;
#pragma unroll
    for (int j = 0; j < 8; ++j) { const int n = (lane >> 3) + 8 * j; const float* s = scr + (8 * cc) * 65 + n;
        uint4 o; o.x = pk2(s[0 * 65], s[1 * 65]); o.y = pk2(s[2 * 65], s[3 * 65]); o.z = pk2(s[4 * 65], s[5 * 65]); o.w = pk2(s[6 * 65], s[7 * 65]);
        *(uint4*)(WT + (size_t)n * D + 8 * cc) = o; }
    asm volatile("s_waitcnt lgkmcnt(0)" ::: "memory");
}
DI void wprep_gate_queue(const Ctx& c, const Blk& B, unsigned char* lds_raw) {
    float* scr = (float*)lds_raw + B.wave * 4160;
    LAS int* slot = (LAS int*)((LAS unsigned char*)lds_raw + 140000);
    unsigned* ctr = (unsigned*)c.ws + 2240;
    for (;;) {
        __syncthreads();
        if (B.tid == 0) *slot = (int)__hip_atomic_fetch_add(ctr, 1u, __ATOMIC_RELAXED, __HIP_MEMORY_SCOPE_AGENT);
        __syncthreads();
        const int bi = *slot;
        if (bi >= N_EARLY * 32) break;
        const int it = bi * 8 + B.wave, m = it >> 8, r = it & 255, nb = r >> 4, kb = r & 15;
        transpose64((m < 32 ? c.w_gate + (size_t)m * D * D : c.w_up + (size_t)(m - 32) * D * D) + (size_t)(kb * 64) * D + nb * 64, (u16*)(c.ws + early_off(m)) + (size_t)(nb * 64) * D + kb * 64, scr, B.lane);
    }
}
DI void ph_wprep_moe(const Ctx& c, const Blk& B, float* lds) {
    float* scr = lds + B.wave * 4160;
    const int lane = B.lane, nit = 3, it0 = B.bid * 24 + B.wave * 3;
    for (int j0 = 0; j0 < nit; ++j0) {
        const int it = it0 + j0;
        const int e = 8 + (it >> 8), r = it & 255, nb = r >> 4, kb = r & 15;
        transpose64(c.w_up + (size_t)e * D * D + (size_t)(kb * 64) * D + nb * 64, (u16*)(c.ws + up_off(e)) + (size_t)(nb * 64) * D + kb * 64, scr, lane);
    }
}
DI void ph_wprep_fourier(const Ctx& c, const Blk& B, float* lds) {
    u16* WFT = (u16*)(c.ws + WS_WFT);
    float* tile = lds; float* ctab = lds + 64 * 129; float* stab = ctab + 128;
    __syncthreads();
    if (B.tid < 128) { ctab[B.tid] = cospif((float)B.tid / 64.f); stab[B.tid] = sinpif((float)B.tid / 64.f); }
    for (int item = B.bid; item < 256; item += B.G) {
        const int g = item >> 6, k0 = ((item >> 2) & 15) * 64, mpart = item & 3;
        __syncthreads();
        for (int i = B.tid; i < 64 * 128; i += 512) { const int r = i >> 7, cc = i & 127; tile[r * 129 + cc] = c.w_in[(size_t)(k0 + r) * IN_COLS + 3104 + g * 128 + cc]; }
        __syncthreads();
        const int k = B.tid & 63, mq = B.tid >> 6;
        for (int mm = 0; mm < 4; ++mm) {
            const int m = mpart * 32 + mq * 4 + mm;
            float fc = 0.f, fs = 0.f;
            for (int cc = 0; cc < 128; ++cc) { const float v = tile[k * 129 + cc]; const int ix = (cc * m) & 127; fc += v * ctab[ix]; fs += v * stab[ix]; }
            WFT[(size_t)(g * 128 + m) * 1024 + k0 + k] = f2bf(fc);
            WFT[(size_t)(512 + g * 128 + m) * 1024 + k0 + k] = f2bf(fs);
        }
    }
    __syncthreads();
}

struct SchedG1 {
    const char* U; const char* WINT; const char* WFT; const char* UEO; int G, c;
    DI bool next(int i, pg::Unit& u) const {
        const int Lx = i * G + c;
        if (Lx >= 1508) return false;
        const char *a, *b;
        if (Lx < 1344) {
            int wgid = Lx; { const int nwg = 1344, q = nwg / 8, r = nwg % 8, xcd = wgid % 8, off = wgid / 8; wgid = (xcd < r ? xcd * (q + 1) : r * (q + 1) + (xcd - r) * q) + off; }
            const int nig = 8 * 21, gid = wgid / nig, fm = gid * 8, gsz = (64 - fm) < 8 ? (64 - fm) : 8;
            u.pm = fm + ((wgid % nig) % gsz); u.pn = (wgid % nig) / gsz; u.kind = 0;
            a = U + (size_t)u.pm * 256 * 2048; b = WINT + (size_t)u.pn * 256 * 2048;
        } else if (Lx < 1380) {
            const int r = Lx - 1344, j = r % 9; u.pm = 64 + r / 9; u.pn = j < 8 ? j : 20; u.kind = 0;
            a = U + (size_t)u.pm * 256 * 2048; b = WINT + (size_t)u.pn * 256 * 2048;
        } else {
            const int r = Lx - 1380; u.pm = r >> 5; u.pn = r & 31; u.kind = 1;
            a = WFT + (size_t)u.pm * 256 * 2048; b = UEO + (size_t)(u.pm >> 1) * 8192 * 2048 + (size_t)u.pn * 256 * 2048;
        }
        u.a0 = a; u.a1 = a + 128 * 2048; u.b0 = b; u.b1 = b + 128 * 2048; u.v00 = u.v01 = u.v10 = u.v11 = 0u;
        u.nt = 16; u.ex = 0;
        return true;
    }
};
DI float fsilu(float v) { return v / (1.f + __expf(-v)); }
DI float fsigm(float v) { return 1.f / (1.f + __expf(-v)); }
struct EpiG1 {
    u16 *QKV, *SZ, *GA, *GB, *FT2; float* BA;
    DI void operator()(const pg::f32x4 (&acc)[2][2][4][2], const pg::Unit& u, int wr, int wc, int fr, int fq) const {
        const int c0 = wc * 32 + 8 * fq;
        if (u.kind == 0 && u.pn == 20) {
            if (wc == 0) {
#pragma unroll
                for (int ai = 0; ai < 2; ++ai)
#pragma unroll
                    for (int m = 0; m < 4; ++m) { const size_t row = (size_t)u.pm * 256 + ai * 128 + wr * 64 + m * 16 + fr;
                        *(pg::f32x4*)(BA + row * 32 + c0) = acc[ai][0][m][0]; *(pg::f32x4*)(BA + row * 32 + c0 + 4) = acc[ai][0][m][1]; }
            }
            return;
        }
        u16* base; size_t pitch; int mode;
        size_t rowbase;
        if (u.kind == 0) {
            rowbase = (size_t)u.pm * 256;
            if (u.pn < 8) { base = QKV + u.pn * 256; pitch = 2048; mode = 0; }
            else if (u.pn < 12) { base = SZ + (u.pn - 8) * 256; pitch = 1024; mode = 1; }
            else if (u.pn < 16) { base = GA + (u.pn - 12) * 256; pitch = 1024; mode = 2; }
            else { base = GB + (u.pn - 16) * 256; pitch = 1024; mode = 2; }
        } else {
            const int cs = u.pm >> 1, bb = u.pn >> 3;
            base = FT2 + ((size_t)bb * 512 + (u.pm & 1) * 256) * 4096 + cs * 2048 + (u.pn & 7) * 256; pitch = 4096; mode = 0; rowbase = 0;
        }
#pragma unroll
        for (int ai = 0; ai < 2; ++ai)
#pragma unroll
            for (int m = 0; m < 4; ++m) { u16* rowp = base + (rowbase + ai * 128 + wr * 64 + m * 16 + fr) * pitch + c0;
#pragma unroll
                for (int bj = 0; bj < 2; ++bj) { pg::f32x4 v0 = acc[ai][bj][m][0], v1 = acc[ai][bj][m][1];
                    if (mode == 1) {
#pragma unroll
                        for (int j = 0; j < 4; ++j) { v0[j] = fsilu(v0[j]); v1[j] = fsilu(v1[j]); } }
                    else if (mode == 2) {
#pragma unroll
                        for (int j = 0; j < 4; ++j) { v0[j] = fsigm(v0[j]); v1[j] = fsigm(v1[j]); } }
                    pg::u32x4 w; w.x = pg::cvt_pk_bf16(v0[0], v0[1]); w.y = pg::cvt_pk_bf16(v0[2], v0[3]); w.z = pg::cvt_pk_bf16(v1[0], v1[1]); w.w = pg::cvt_pk_bf16(v1[2], v1[3]);
                    *(pg::u32x4*)(rowp + bj * 128) = w; } }
    }
};
DI void ph_gemm1(const Ctx& c, const Blk& B, unsigned char* lds_raw) {
    SchedG1 S; S.U = c.ws + WS_U; S.WINT = c.ws + WS_WINT; S.WFT = c.ws + WS_WFT; S.UEO = c.ws + WS_FT2N; S.G = B.G; S.c = B.bid;
    EpiG1 E{(u16*)(c.ws + WS_QKV), (u16*)(c.ws + WS_SZ), (u16*)(c.ws + WS_GA), (u16*)(c.ws + WS_GB), (u16*)((char*)c.out + FE_OUT_OFF), (float*)(c.ws + WS_BA)};
    pg::gemm_phase<true, false>((LAS unsigned char*)lds_raw, B.tid, 1024, 1024, S, E);
}

struct SchedTile {
    const char* A; const char* Bt; int lda, G, c;
    DI bool next(int i, pg::Unit& u) const {
        const int Lx = i * G + c; if (Lx >= 256) return false;
        int wgid = Lx; { const int xcd = wgid % 8, off = wgid / 8; wgid = xcd * 32 + off; }
        u.pm = (wgid >> 5) * 8 + (wgid & 7); u.pn = (wgid >> 3) & 3; u.kind = 0; u.ex = 0; u.nt = lda / 64;
        const char* a = A + (size_t)u.pm * 256 * lda * 2; const char* b = Bt + (size_t)u.pn * 256 * lda * 2;
        u.a0 = a; u.a1 = a + (size_t)128 * lda * 2; u.b0 = b; u.b1 = b + (size_t)128 * lda * 2; u.v00 = u.v01 = u.v10 = u.v11 = 0u;
        return true;
    }
};
DI pg::f32x4 bf4lo(pg::u32x4 w, int half) {
    const unsigned a = half ? w.z : w.x, b = half ? w.w : w.y;
    return (pg::f32x4){__uint_as_float(a << 16), __uint_as_float(a & 0xffff0000u), __uint_as_float(b << 16), __uint_as_float(b & 0xffff0000u)};
}
template <int MODE>
struct EpiMerge {
    u16* OUT; const u16* G; const u16* T1;
    DI void operator()(const pg::f32x4 (&acc)[2][2][4][2], const pg::Unit& u, int wr, int wc, int fr, int fq) const {
        const int c0 = u.pn * 256 + wc * 32 + 8 * fq;
#pragma unroll
        for (int ai = 0; ai < 2; ++ai)
#pragma unroll
            for (int m = 0; m < 4; ++m) { const size_t off = (size_t)(u.pm * 256 + ai * 128 + wr * 64 + m * 16 + fr) * 1024 + c0;
#pragma unroll
                for (int bj = 0; bj < 2; ++bj) {
                    const pg::u32x4 gw = *(const pg::u32x4*)(G + off + bj * 128);
                    pg::f32x4 v0 = acc[ai][bj][m][0] * bf4lo(gw, 0), v1 = acc[ai][bj][m][1] * bf4lo(gw, 1);
                    if (MODE == 1) { const pg::u32x4 tw = *(const pg::u32x4*)(T1 + off + bj * 128); v0 += bf4lo(tw, 0); v1 += bf4lo(tw, 1); }
                    pg::u32x4 w; w.x = pg::cvt_pk_bf16(v0[0], v0[1]); w.y = pg::cvt_pk_bf16(v0[2], v0[3]); w.z = pg::cvt_pk_bf16(v1[0], v1[1]); w.w = pg::cvt_pk_bf16(v1[2], v1[3]);
                    *(pg::u32x4*)(OUT + off + bj * 128) = w; } }
    }
};
struct EpiX1f {
    float* X1; const float* x; const float* MOD; float* SSP;
    DI void operator()(const pg::f32x4 (&acc)[2][2][4][2], const pg::Unit& u, int wr, int wc, int fr, int fq) const {
        const int c0 = u.pn * 256 + wc * 32 + 4 * fq;
        const float* g1 = MOD + (u.pm >> 4) * 6144 + 2048;
#pragma unroll
        for (int ai = 0; ai < 2; ++ai)
#pragma unroll
            for (int m = 0; m < 4; ++m) { const int row = u.pm * 256 + ai * 128 + wr * 64 + m * 16 + fr; const size_t off = (size_t)row * 1024 + c0;
                float ss = 0.f;
#pragma unroll
                for (int bj = 0; bj < 2; ++bj)
#pragma unroll
                    for (int n = 0; n < 2; ++n) { const int cc = bj * 128 + n * 16;
                        const pg::f32x4 xv = *(const pg::f32x4*)(x + off + cc), gv = *(const pg::f32x4*)(g1 + c0 + cc);
                        const pg::f32x4 o = xv + gv * acc[ai][bj][m][n];
                        ss += o[0] * o[0] + o[1] * o[1] + o[2] * o[2] + o[3] * o[3];
                        *(pg::f32x4*)(X1 + off + cc) = o; }
                ss += __shfl_xor(ss, 16); ss += __shfl_xor(ss, 32);
                if (fq == 0) SSP[(size_t)(u.pn * 4 + wc) * NT + row] = ss; }
    }
};
DI void ph_merge_ab(const Ctx& c, const Blk& B, unsigned char* lds_raw) {
    { SchedTile S{c.ws + WS_FM2, c.ws + WS_WFOT, 512, B.G, B.bid}; EpiMerge<0> E{(u16*)(c.ws + WS_T1), (const u16*)(c.ws + WS_GA), nullptr};
      pg::gemm_phase<true, false>((LAS unsigned char*)lds_raw, B.tid, 512, 512, S, E); }
    { SchedTile S{c.ws + WS_OB, c.ws + WS_WGOT, 1024, B.G, B.bid}; EpiMerge<1> E{(u16*)(c.ws + WS_M1), (const u16*)(c.ws + WS_GB), (const u16*)(c.ws + WS_T1)};
      pg::gemm_phase<true, false>((LAS unsigned char*)lds_raw, B.tid, 1024, 1024, S, E); }
}
DI void ph_merge_c(const Ctx& c, const Blk& B, unsigned char* lds_raw) {
    SchedTile S{c.ws + WS_M1, c.ws + WS_WMOT, 1024, B.G, B.bid}; EpiX1f E{c.out, c.x, (const float*)(c.ws + WS_MOD), (float*)(c.ws + WS_SSP)};
    pg::gemm_phase<false, false>((LAS unsigned char*)lds_raw, B.tid, 1024, 1024, S, E);
}

constexpr int MOE_TAB = 131072 + 1024;
DI void moe_tables256(const Ctx& c, const Blk& B, LAS int* T) {
    const int* cnt = (const int*)(c.ws + WS_CTL);
    __syncthreads();
    if (B.tid == 0) { int ts = 0; for (int e = 0; e < 32; ++e) { const int n = cnt[64 * e]; T[e] = ts; T[40 + e] = n; ts += (n + 255) >> 8; } T[32] = ts; }
    __syncthreads();
}
template <bool DOWN>
struct SchedMoE {
    const LAS int* T; const char* A; const char* W0; const char* W1; const int* TOKE; int G, c, tid;
    DI bool next(int i, pg::Unit& u) const {
        constexpr int NPN = DOWN ? 4 : 8;
        const int total = T[32] * NPN;
        const int Lx = i * G + (c & 7) * (G >> 3) + (c >> 3);
        if (Lx >= total) return false;
        const int tl = Lx / NPN, pn = Lx % NPN;
        int e = 0;
        for (int k = 1; k < 32; ++k) if (tl >= T[k]) e = k;
        const int mt = tl - T[e];
        u.pm = tl; u.pn = pn; u.kind = e; u.ex = mt; u.nt = 16;
        if (DOWN) {
            const char* a = A + (size_t)tl * 256 * 2048; const char* b = W0 + ((size_t)e * 1024 + pn * 256) * 2048;
            u.a0 = a; u.a1 = a + 128 * 2048; u.b0 = b; u.b1 = b + 128 * 2048; u.v00 = u.v01 = u.v10 = u.v11 = 0u;
        } else {
            const size_t wo = ((size_t)e * 1024 + pn * 128) * 2048;
            u.a0 = A; u.a1 = A; u.b0 = W0 + gate_off(e) + (size_t)pn * 128 * 2048; u.b1 = W0 + up_off(e) + (size_t)pn * 128 * 2048; (void)wo;
            const int n = T[40 + e], r0 = mt * 256; const int* tk = TOKE + e * CAP;
            int R0, C0, R1, C1; pg::lane_rc(tid, 0, R0, C0); pg::lane_rc(tid, 1, R1, C1);
            const int i00 = min(r0 + R0, n - 1), i01 = min(r0 + R1, n - 1), i10 = min(r0 + 128 + R0, n - 1), i11 = min(r0 + 128 + R1, n - 1);
            u.v00 = (unsigned)(tk[i00] * 1024 + C0) * 2u; u.v01 = (unsigned)(tk[i01] * 1024 + C1) * 2u;
            u.v10 = (unsigned)(tk[i10] * 1024 + C0) * 2u; u.v11 = (unsigned)(tk[i11] * 1024 + C1) * 2u;
        }
        return true;
    }
};
struct EpiGU {
    u16* ACT; const float* bg; const float* bu;
    DI void operator()(const pg::f32x4 (&acc)[2][2][4][2], const pg::Unit& u, int wr, int wc, int fr, int fq) const {
        const int col = u.pn * 128 + wc * 32 + 8 * fq;
        const float* pg_ = bg + u.kind * 1024 + col; const float* pu_ = bu + u.kind * 1024 + col;
        const pg::f32x4 bg0 = *(const pg::f32x4*)pg_, bg1 = *(const pg::f32x4*)(pg_ + 4), bu0 = *(const pg::f32x4*)pu_, bu1 = *(const pg::f32x4*)(pu_ + 4);
#pragma unroll
        for (int ai = 0; ai < 2; ++ai)
#pragma unroll
            for (int m = 0; m < 4; ++m) {
                float o[8];
#pragma unroll
                for (int n = 0; n < 2; ++n)
#pragma unroll
                    for (int j = 0; j < 4; ++j) {
                        const float gt = fminf(acc[ai][0][m][n][j] + (n ? bg1[j] : bg0[j]), 7.f);
                        const float up = fminf(fmaxf(acc[ai][1][m][n][j] + (n ? bu1[j] : bu0[j]), -7.f), 7.f);
                        o[n * 4 + j] = (up + 1.f) * gt / (1.f + __expf(-1.702f * gt));
                    }
                pg::u32x4 w; w.x = pg::cvt_pk_bf16(o[0], o[1]); w.y = pg::cvt_pk_bf16(o[2], o[3]); w.z = pg::cvt_pk_bf16(o[4], o[5]); w.w = pg::cvt_pk_bf16(o[6], o[7]);
                *(pg::u32x4*)(ACT + (size_t)(u.pm * 256 + ai * 128 + wr * 64 + m * 16 + fr) * 1024 + col) = w;
            }
    }
};
struct EpiDown {
    u16* Y; const float* bd; const float* WTE;
    DI void operator()(const pg::f32x4 (&acc)[2][2][4][2], const pg::Unit& u, int wr, int wc, int fr, int fq) const {
        const int c0 = u.pn * 256 + wc * 32 + 8 * fq;
        const float* pb = bd + u.kind * 1024 + c0;
        pg::f32x4 b0[2], b1[2];
#pragma unroll
        for (int bj = 0; bj < 2; ++bj) { b0[bj] = *(const pg::f32x4*)(pb + bj * 128); b1[bj] = *(const pg::f32x4*)(pb + bj * 128 + 4); }
#pragma unroll
        for (int ai = 0; ai < 2; ++ai)
#pragma unroll
            for (int m = 0; m < 4; ++m) { const int rt = ai * 128 + wr * 64 + m * 16 + fr;
                const float wt = WTE[u.kind * CAP + u.ex * 256 + rt];
                u16* rowp = Y + (size_t)(u.pm * 256 + rt) * 1024 + c0;
#pragma unroll
                for (int bj = 0; bj < 2; ++bj) { const pg::f32x4 v0 = (acc[ai][bj][m][0] + b0[bj]) * wt, v1 = (acc[ai][bj][m][1] + b1[bj]) * wt;
                    pg::u32x4 w; w.x = pg::cvt_pk_bf16(v0[0], v0[1]); w.y = pg::cvt_pk_bf16(v0[2], v0[3]); w.z = pg::cvt_pk_bf16(v1[0], v1[1]); w.w = pg::cvt_pk_bf16(v1[2], v1[3]);
                    *(pg::u32x4*)(rowp + bj * 128) = w; } }
    }
};
DI void wprep_down_queue(const Ctx& c, const Blk& B, unsigned char* lds_raw) {
    float* scr = (float*)lds_raw + B.wave * 4160;
    LAS int* slot = (LAS int*)((LAS unsigned char*)lds_raw + 140000);
    unsigned* ctr = (unsigned*)c.ws + 2112;
    const int lane = B.lane;
    for (;;) {
        __syncthreads();
        if (B.tid == 0) *slot = (int)__hip_atomic_fetch_add(ctr, 1u, __ATOMIC_RELAXED, __HIP_MEMORY_SCOPE_AGENT);
        __syncthreads();
        const int bi = *slot;
        if (bi >= 1024) break;
        const int it = bi * 8 + B.wave, e = it >> 8, r = it & 255, nb = r >> 4, kb = r & 15;
        transpose64(c.w_down + (size_t)e * D * D + (size_t)(kb * 64) * D + nb * 64, (u16*)(c.ws + WS_WDT) + (size_t)e * D * D + (size_t)(nb * 64) * D + kb * 64, scr, lane);
    }
}
DI void ph_moe_gu(const Ctx& c, const Blk& B, unsigned char* lds_raw) {
    LAS int* T = (LAS int*)((LAS unsigned char*)lds_raw + MOE_TAB);
    moe_tables256(c, B, T);
    SchedMoE<false> S{T, c.ws + WS_H2, c.ws, c.ws + WS_WUT, (const int*)(c.ws + WS_TOKE), B.G, B.bid, B.tid};
    EpiGU E{(u16*)(c.ws + WS_ACT), c.b_gate, c.b_up};
    pg::gemm_phase<true, true>((LAS unsigned char*)lds_raw, B.tid, 1024, 1024, S, E);
}
DI void ph_moe_down(const Ctx& c, const Blk& B, unsigned char* lds_raw) {
    LAS int* T = (LAS int*)((LAS unsigned char*)lds_raw + MOE_TAB);
    moe_tables256(c, B, T);
    SchedMoE<true> S{T, c.ws + WS_ACT, c.ws + WS_WDT, nullptr, nullptr, B.G, B.bid, B.tid};
    EpiDown E{(u16*)(c.ws + WS_Y), c.b_down, (const float*)(c.ws + WS_WTE)};
    pg::gemm_phase<true, false>((LAS unsigned char*)lds_raw, B.tid, 1024, 1024, S, E);
}


typedef short bf16x8 __attribute__((ext_vector_type(8)));
typedef short bf16x4 __attribute__((ext_vector_type(4)));
typedef float f32x4 __attribute__((ext_vector_type(4)));
DI f32x4 mfma16(bf16x8 a, bf16x8 b, f32x4 c) { return __builtin_amdgcn_mfma_f32_16x16x32_bf16(a, b, c, 0, 0, 0); }
DI bf16x8 frag_nat(const LAS unsigned char* p) { return *(const LAS bf16x8*)p; }
DI bf16x8 frag_perm(const LAS unsigned char* p) {
    const bf16x4 lo = *(const LAS bf16x4*)p, hi = *(const LAS bf16x4*)(p + 32);
    return __builtin_shufflevector(lo, hi, 0, 1, 2, 3, 4, 5, 6, 7);
}
DI bf16x8 pack8(f32x4 a, f32x4 b) {
    typedef unsigned u32x4_ __attribute__((ext_vector_type(4)));
    u32x4_ w; w.x = pg::cvt_pk_bf16(a[0], a[1]); w.y = pg::cvt_pk_bf16(a[2], a[3]); w.z = pg::cvt_pk_bf16(b[0], b[1]); w.w = pg::cvt_pk_bf16(b[2], b[3]);
    return __builtin_bit_cast(bf16x8, w);
}
DI unsigned long long pack4(f32x4 a) { return (unsigned long long)pg::cvt_pk_bf16(a[0], a[1]) | ((unsigned long long)pg::cvt_pk_bf16(a[2], a[3]) << 32); }

constexpr int PL_Q = 0, PL_K = 17408, PL_KT = 36864, PL_VT = 55296, PL_KK = 92160, PL_G = 108544, PL_T01 = 110592, PL_T23 = 0;

#define DEF_N0(b_) ((b_) < 2 ? 31 : 37)
#define DEF_FLAG(d_) (4096 + 16 * (d_))
DI void ph_gdn_prep(const Ctx& c, const Blk& B, unsigned char* lds_raw, const int mode) {
    LAS unsigned char* lds = (LAS unsigned char*)lds_raw;
    const u16* QKV = (const u16*)(c.ws + WS_QKV); const float* BA = (const float*)(c.ws + WS_BA);
    const int tid = B.tid, lane = B.lane, wave = B.wave;
    for (int m = mode ? B.bid - 128 : B.bid; m < (mode ? 64 : 1024); m += (mode ? B.G - 128 : B.G)) {
        int b, n, hq;
        if (mode) { b = m >> 4; n = DEF_N0(b) + ((m >> 2) & 3); hq = m & 3; }
        else { b = m >> 8; const int j = (m >> 2) & 63; hq = m & 3; n = j < DEF_N0(b) ? j : j + 4; }
        const bool isctx = n < 4;
        unsigned char* imgh = (unsigned char*)c.ws + WS_IMGH + (size_t)((b * 68 + n) * 4 + hq) * IMGH_STRIDE;
        {
            const int cg = tid & 127, run = tid >> 7, c0 = run * 16;
            const int gcol = cg < 32 ? (hq * 128 + cg * 4) : cg < 64 ? (512 + hq * 128 + (cg - 32) * 4) : (1024 + hq * 256 + (cg - 64) * 4);
            float w[9][4];
#pragma unroll
            for (int t = 0; t < 9; ++t) { const float4 wv = *(const float4*)(c.conv_w + t * 2048 + gcol); w[t][0] = wv.x; w[t][1] = wv.y; w[t][2] = wv.z; w[t][3] = wv.w; }
            int rb[3];
#pragma unroll
            for (int dr = 0; dr < 3; ++dr) {
                if (isctx) rb[dr] = (dr == 1) ? (NT + b * CT + n * 64) : -1;
                else { const int gr = (n - 4) + dr - 1; rb[dr] = (gr >= 0 && gr < 64) ? (b * L + gr * 64) : -1; }
            }
            const int cmin = isctx ? (n == 0 ? 0 : -1) : 0, cmax = isctx ? (n == 3 ? 63 : 64) : 63;
            float win[3][3][4];
#define LOADCOL(dst_dc, colv) do { _Pragma("unroll") for (int dr = 0; dr < 3; ++dr) { \
                const bool ok = rb[dr] >= 0 && (colv) >= cmin && (colv) <= cmax; \
                ushort4 x4 = make_ushort4(0, 0, 0, 0); if (ok) x4 = *(const ushort4*)(QKV + (size_t)(rb[dr] + (colv)) * 2048 + gcol); \
                win[dr][dst_dc][0] = bf2f(x4.x); win[dr][dst_dc][1] = bf2f(x4.y); win[dr][dst_dc][2] = bf2f(x4.z); win[dr][dst_dc][3] = bf2f(x4.w); } } while (0)
            LOADCOL(0, c0 - 1); LOADCOL(1, c0);
#pragma unroll
            for (int hf = 0; hf < 2; ++hf) {
                float outv[8][4];
#pragma unroll
                for (int i = 0; i < 8; ++i) {
                    LOADCOL(2, c0 + hf * 8 + i + 1);
#pragma unroll
                    for (int ch = 0; ch < 4; ++ch) {
                        float a = 0.f;
#pragma unroll
                        for (int dr = 0; dr < 3; ++dr)
#pragma unroll
                            for (int dc = 0; dc < 3; ++dc) a += win[dr][dc][ch] * w[dr * 3 + dc][ch];
                        outv[i][ch] = a / (1.f + __expf(-a));
                    }
#pragma unroll
                    for (int dr = 0; dr < 3; ++dr)
#pragma unroll
                        for (int ch = 0; ch < 4; ++ch) { win[dr][0][ch] = win[dr][1][ch]; win[dr][1][ch] = win[dr][2][ch]; }
                }
                const int cb0 = c0 + hf * 8;
                if ((wave & 1) == 0) {
#pragma unroll
                    for (int i = 0; i < 8; ++i) {
                        float ss = outv[i][0] * outv[i][0] + outv[i][1] * outv[i][1] + outv[i][2] * outv[i][2] + outv[i][3] * outv[i][3];
                        ss += __shfl_xor(ss, 1); ss += __shfl_xor(ss, 2); ss += __shfl_xor(ss, 4); ss += __shfl_xor(ss, 8); ss += __shfl_xor(ss, 16);
                        const float sc = rsqrtf(ss + EPS) * (lane < 32 ? 0.08838834764831845f : 1.f);
#pragma unroll
                        for (int ch = 0; ch < 4; ++ch) outv[i][ch] *= sc;
                    }
                    const int d0 = (lane & 31) * 4;
                    LAS unsigned char* nat = lds + (lane < 32 ? PL_Q : PL_K);
#pragma unroll
                    for (int i = 0; i < 8; ++i) *(LAS unsigned long long*)(nat + (cb0 + i) * 272 + d0 * 2) = pack4((f32x4){outv[i][0], outv[i][1], outv[i][2], outv[i][3]});
                    if (lane >= 32) {
#pragma unroll
                        for (int ch = 0; ch < 4; ++ch)
                            *(LAS bf16x8*)(lds + PL_KT + (d0 + ch) * 144 + cb0 * 2) = pack8((f32x4){outv[0][ch], outv[1][ch], outv[2][ch], outv[3][ch]}, (f32x4){outv[4][ch], outv[5][ch], outv[6][ch], outv[7][ch]});
                    }
                } else {
                    const int dv0 = (cg - 64) * 4;
#pragma unroll
                    for (int ch = 0; ch < 4; ++ch)
                        *(LAS bf16x8*)(lds + PL_VT + (dv0 + ch) * 144 + cb0 * 2) = pack8((f32x4){outv[0][ch], outv[1][ch], outv[2][ch], outv[3][ch]}, (f32x4){outv[4][ch], outv[5][ch], outv[6][ch], outv[7][ch]});
                }
                asm volatile("" ::: "memory");
            }
#undef LOADCOL
        }
        if (wave < 4) {
            const int hvl = wave >> 1, dir = wave & 1, hv = hq * 2 + hvl;
            const int row = isctx ? (NT + b * CT + n * 64 + lane) : (b * L + (n - 4) * 64 + lane);
            const float beta = 1.f / (1.f + expf(-BA[(size_t)row * 32 + dir * 8 + hv]));
            const float lg = -expf(c.a_log[dir * 8 + hv]) * softplusf_(BA[(size_t)row * 32 + 16 + dir * 8 + hv] + c.dt_bias[dir * 8 + hv]);
            float gc = lg;
            if (dir == 0) {
#pragma unroll
                for (int o = 1; o < 64; o <<= 1) { const float t = __shfl_up(gc, o); if (lane >= o) gc += t; }
            } else {
#pragma unroll
                for (int o = 1; o < 64; o <<= 1) { const float t = __shfl_down(gc, o); if (lane + o < 64) gc += t; }
            }
            const float ge = __shfl(gc, dir ? 0 : 63);
            LAS float* gl = (LAS float*)(lds + PL_G + wave * 512);
            gl[lane] = beta; gl[64 + lane] = gc;
            float* gi = (float*)((unsigned char*)c.ws + WS_IMGHD + (size_t)(((b * 68 + n) * 8 + hv) * 2 + dir) * IMGHD_STRIDE + ID_G);
            gi[lane] = expf(gc); gi[64 + lane] = expf(ge - gc); if (lane == 0) gi[128] = expf(ge);
        }
        __syncthreads();
        for (int ch = tid; ch < 1088 + 1152; ch += 512) {
            if (ch < 1088) *(pg::u32x4*)(imgh + IH_Q + ch * 16) = *(const LAS pg::u32x4*)(lds + PL_Q + ch * 16);
            else *(pg::u32x4*)(imgh + IH_KT + (ch - 1088) * 16) = *(const LAS pg::u32x4*)(lds + PL_KT + (ch - 1088) * 16);
        }
        {
            const int it = wave & 3, fr = lane & 15, qd = lane >> 4;
            const LAS unsigned char* xs = lds + (wave < 4 ? PL_K : PL_Q);
            bf16x8 xf[4];
#pragma unroll
            for (int ks = 0; ks < 4; ++ks) xf[ks] = frag_nat(xs + (it * 16 + fr) * 272 + ks * 64 + qd * 16);
            const int i = it * 16 + fr;
#pragma unroll
            for (int g = 0; g < 2; ++g) {
                f32x4 acc[2];
#pragma unroll
                for (int sub = 0; sub < 2; ++sub) {
                    acc[sub] = (f32x4){0.f, 0.f, 0.f, 0.f};
                    const int prow = 32 * g + 8 * (fr >> 2) + 4 * sub + (fr & 3);
#pragma unroll
                    for (int ks = 0; ks < 4; ++ks) acc[sub] = mfma16(frag_nat(lds + PL_K + prow * 272 + ks * 64 + qd * 16), xf[ks], acc[sub]);
                }
                const int j0 = 32 * g + 8 * qd;
                if (wave < 4) { *(LAS f32x4*)(lds + PL_KK + (i * 64 + j0) * 4) = acc[0]; *(LAS f32x4*)(lds + PL_KK + (i * 64 + j0 + 4) * 4) = acc[1]; }
                else {
#pragma unroll
                    for (int cb = 0; cb < 4; ++cb) {
                        const int dir = cb & 1, hv = hq * 2 + (cb >> 1);
                        const LAS float* gl = (const LAS float*)(lds + PL_G + cb * 512) + 64;
                        const float gi_ = gl[i]; const f32x4 gj0 = *(const LAS f32x4*)(gl + j0), gj1 = *(const LAS f32x4*)(gl + j0 + 4);
                        f32x4 o0, o1;
#pragma unroll
                        for (int r = 0; r < 4; ++r) { const int ja = j0 + r, jb = j0 + 4 + r; const bool ka = dir ? (ja >= i) : (ja <= i), kb = dir ? (jb >= i) : (jb <= i);
                            o0[r] = ka ? acc[0][r] * __expf(gi_ - gj0[r]) : 0.f; o1[r] = kb ? acc[1][r] * __expf(gi_ - gj1[r]) : 0.f; }
                        unsigned char* qki = (unsigned char*)c.ws + WS_IMGHD + (size_t)(((b * 68 + n) * 8 + hv) * 2 + dir) * IMGHD_STRIDE + ID_QK;
                        *(bf16x8*)(qki + i * 144 + j0 * 2) = pack8(o0, o1);
                    }
                }
            }
        }
        __syncthreads();
        if (wave < 4) {
            int dir = wave & 1, ln = lane; asm volatile("" : "+s"(dir), "+v"(ln));
            const LAS float* gl = (const LAS float*)(lds + PL_G + wave * 512);
            LAS unsigned char* tk = lds + (wave < 2 ? PL_T01 + wave * 18432 : PL_T23 + (wave - 2) * 18432);
            LAS float* Tf = (LAS float*)tk;
            const int q = ln >> 4, x = ln & 15;
#define TOKN(g_) (dir ? 63 - (g_) : (g_))
#define AFUN(gr_, gc_) (gl[TOKN(gr_)] * (*(const LAS float*)(lds + PL_KK + (TOKN(gr_) * 64 + TOKN(gc_)) * 4)) * __expf(gl[64 + TOKN(gr_)] - gl[64 + TOKN(gc_)]))
            {
                float Dc[16];
#pragma unroll
                for (int r = 0; r < 16; ++r) Dc[r] = (r == 0) ? ((x == 0) ? 1.f : 0.f) : 0.f;
#pragma unroll
                for (int r = 1; r < 16; ++r) {
                    float a = AFUN(16 * q + r, 16 * q + x);
                    a = (x < r) ? a : 0.f;
                    float s0 = 0.f, s1 = 0.f;
#pragma unroll
                    for (int m = 0; m < r; ++m) {
                        const float am = __uint_as_float((unsigned)__builtin_amdgcn_ds_bpermute(((ln & 48) + m) << 2, (int)__float_as_uint(a)));
                        if (m & 1) s1 += am * Dc[m]; else s0 += am * Dc[m];
                    }
                    Dc[r] = ((x == r) ? 1.f : 0.f) - (s0 + s1);
                }
#pragma unroll
                for (int r = 0; r < 16; ++r) Tf[(16 * q + r) * 64 + 16 * q + x] = Dc[r];
            }
            asm volatile("s_waitcnt lgkmcnt(0)" ::: "memory");
            f32x4 E10, E20, E21, E30, E31, E32;
#define EBLK(dst, r_, k_) do { dst = (f32x4){0.f, 0.f, 0.f, 0.f}; const f32x4 dr_ = *(const LAS f32x4*)(Tf + (16 * (r_) + x) * 64 + 16 * (r_) + 4 * q); \
                _Pragma("unroll") for (int s_ = 0; s_ < 4; ++s_) dst = __builtin_amdgcn_mfma_f32_16x16x4f32(AFUN(16 * (r_) + 4 * q + s_, 16 * (k_) + x), dr_[s_], dst, 0, 0, 0); } while (0)
            EBLK(E10, 1, 0); EBLK(E20, 2, 0); EBLK(E21, 2, 1); EBLK(E30, 3, 0); EBLK(E31, 3, 1); EBLK(E32, 3, 2);
#undef EBLK
#define TACC(acc, E_, k_, c_) do { _Pragma("unroll") for (int s_ = 0; s_ < 4; ++s_) acc = __builtin_amdgcn_mfma_f32_16x16x4f32(E_[s_], Tf[(16 * (k_) + 4 * q + s_) * 64 + 16 * (c_) + x], acc, 0, 0, 0); } while (0)
#define TSTORE(acc, r_, c_) do { _Pragma("unroll") for (int r2_ = 0; r2_ < 4; ++r2_) Tf[(16 * (r_) + 4 * q + r2_) * 64 + 16 * (c_) + x] = -acc[r2_]; } while (0)
            {
                f32x4 t10 = (f32x4){0.f, 0.f, 0.f, 0.f}, t21 = t10, t32 = t10;
                TACC(t10, E10, 0, 0); TACC(t21, E21, 1, 1); TACC(t32, E32, 2, 2);
                TSTORE(t10, 1, 0); TSTORE(t21, 2, 1); TSTORE(t32, 3, 2);
                asm volatile("s_waitcnt lgkmcnt(0)" ::: "memory");
                f32x4 t20 = (f32x4){0.f, 0.f, 0.f, 0.f}, t31 = t20;
                TACC(t20, E20, 0, 0); TACC(t20, E21, 1, 0); TACC(t31, E31, 1, 1); TACC(t31, E32, 2, 1);
                TSTORE(t20, 2, 0); TSTORE(t31, 3, 1);
                asm volatile("s_waitcnt lgkmcnt(0)" ::: "memory");
                f32x4 t30 = (f32x4){0.f, 0.f, 0.f, 0.f};
                TACC(t30, E30, 0, 0); TACC(t30, E31, 1, 0); TACC(t30, E32, 2, 0);
                TSTORE(t30, 3, 0);
                asm volatile("s_waitcnt lgkmcnt(0)" ::: "memory");
            }
#undef TACC
#undef TSTORE
#undef AFUN
            const int jn = TOKN(ln);
            const float gcj = gl[64 + jn], betaj = gl[jn];
            float Tc[64];
#pragma unroll
            for (int i = 0; i < 64; ++i) { const float v = Tf[i * 64 + ln]; Tc[i] = (i >= (ln & 48)) ? v : 0.f; }
            asm volatile("s_waitcnt lgkmcnt(0)" ::: "memory");
            const float sk_ = betaj * __expf(gcj), sv_ = betaj;
#pragma unroll
            for (int i = 0; i < 64; ++i) {
                const int in = TOKN(i);
                *(LAS u16*)(tk + in * 144 + jn * 2) = f2bf(Tc[i] * sk_);
                *(LAS u16*)(tk + 9216 + in * 144 + jn * 2) = f2bf(Tc[i] * sv_);
            }
#undef TOKN
        }
        __syncthreads();
        {
            const int cb = wave >> 1, typ = wave & 1, dir = cb & 1, hvl = cb >> 1, hv = hq * 2 + hvl, fr = lane & 15, qd = lane >> 4;
            const LAS unsigned char* tb = lds + (cb < 2 ? PL_T01 + cb * 18432 : PL_T23 + (cb - 2) * 18432) + typ * 9216;
            unsigned char* img = (unsigned char*)c.ws + WS_IMGHD + (size_t)(((b * 68 + n) * 8 + hv) * 2 + dir) * IMGHD_STRIDE;
            const int prm = 8 * (fr >> 2) + (fr & 3);
            bf16x8 tf[4][2];
#pragma unroll
            for (int it = 0; it < 4; ++it) { const int trow = typ ? (32 * (it >> 1) + prm + 4 * (it & 1)) : (it * 16 + fr);
#pragma unroll
                for (int ks = 0; ks < 2; ++ks) tf[it][ks] = frag_nat(tb + trow * 144 + ks * 64 + qd * 16); }
            const LAS unsigned char* xb = lds + (typ == 0 ? PL_KT : PL_VT + hvl * 128 * 144);
#pragma unroll
            for (int dg = 0; dg < 4; ++dg) {
                bf16x8 xf[2][2];
#pragma unroll
                for (int sub = 0; sub < 2; ++sub) { const int xrow = typ ? (32 * dg + 16 * sub + fr) : (32 * dg + prm + 4 * sub);
#pragma unroll
                    for (int ks = 0; ks < 2; ++ks) xf[sub][ks] = frag_nat(xb + xrow * 144 + ks * 64 + qd * 16); }
                if (typ == 0) {
#pragma unroll
                    for (int it = 0; it < 4; ++it) {
                        f32x4 a0 = (f32x4){0.f, 0.f, 0.f, 0.f}, a1 = a0;
#pragma unroll
                        for (int ks = 0; ks < 2; ++ks) { a0 = mfma16(xf[0][ks], tf[it][ks], a0); a1 = mfma16(xf[1][ks], tf[it][ks], a1); }
                        *(bf16x8*)(img + ID_W + (it * 16 + fr) * 272 + (32 * dg + 8 * qd) * 2) = pack8(-a0, -a1);
                    }
                } else {
#pragma unroll
                    for (int sub2 = 0; sub2 < 2; ++sub2)
#pragma unroll
                        for (int h = 0; h < 2; ++h) {
                            f32x4 a0 = (f32x4){0.f, 0.f, 0.f, 0.f}, a1 = a0;
#pragma unroll
                            for (int ks = 0; ks < 2; ++ks) { a0 = mfma16(tf[2 * h][ks], xf[sub2][ks], a0); a1 = mfma16(tf[2 * h + 1][ks], xf[sub2][ks], a1); }
                            *(bf16x8*)(img + ID_UT + (32 * dg + 16 * sub2 + fr) * 128 + (32 * h + 8 * qd) * 2) = pack8(a0, a1);
                        }
                }
            }
        }
        if (mode) asm volatile("s_waitcnt vmcnt(0)" ::: "memory");
        __syncthreads();
        if (mode && tid == 0) {
            __builtin_amdgcn_fence(__ATOMIC_RELEASE, "agent");
            __hip_atomic_store((unsigned*)c.ws + DEF_FLAG(m), 1u, __ATOMIC_RELEASE, __HIP_MEMORY_SCOPE_AGENT);
        }
    }
}

constexpr int SB_W = 0, SB_QK = 17408, SB_G = 26624, SB_Q = 27648, SB_KT = 45056, SB_BYTES = 63488;
DI void ph_gdn_scan(const Ctx& c, const Blk& B, unsigned char* lds_raw, int first) {
    const int me = B.bid - first;
    if (me < 0 || me >= 128) return;
    const int item = (me & 7) + 8 * (me >> 4), half = (me >> 3) & 1;
    LAS unsigned char* lds = (LAS unsigned char*)lds_raw;
    const int dir = item & 1, hv = (item >> 1) & 7, b = item >> 4, hq = hv >> 1;
    const bool cw = B.wave < 4;
    const int tid = B.tid, lane = B.lane, wave = B.wave, fr = lane & 15, qd = lane >> 4;
    const unsigned char* imgh0 = (const unsigned char*)c.ws + WS_IMGH; const unsigned char* imghd0 = (const unsigned char*)c.ws + WS_IMGHD;
    u16* O = (u16*)(c.ws + WS_O2);
#define CHUNK_OF(s) (dir ? ((s) < 4 ? 3 - (s) : 71 - (s)) : (s))
#define IMGH_OF(n) (imgh0 + (size_t)((b * 68 + (n)) * 4 + hq) * IMGH_STRIDE)
#define IMGHD_OF(n) (imghd0 + (size_t)(((b * 68 + (n)) * 8 + hv) * 2 + dir) * IMGHD_STRIDE)
#define DMA_STEP(n, buf) do { if (wave >= 4 && wave < 7) { const unsigned char* s_hd = IMGHD_OF(n); const unsigned char* s_h = IMGH_OF(n); \
        _Pragma("unroll") for (int it_ = 0; it_ < 21; ++it_) { const int p_ = it_ * 3 + (wave - 4); \
            if (p_ < 27) __builtin_amdgcn_global_load_lds((const unsigned*)(s_hd + p_ * 1024 + lane * 16), (LAS unsigned*)(lds + (buf) * SB_BYTES + p_ * 1024), 16, 0, 0); \
            else if (p_ < 62) __builtin_amdgcn_global_load_lds((const unsigned*)(s_h + (p_ - 27) * 1024 + lane * 16), (LAS unsigned*)(lds + (buf) * SB_BYTES + p_ * 1024), 16, 0, 0); } } } while (0)
#define STEP_BARRIER() do { if (wave == 7) asm volatile("s_waitcnt lgkmcnt(0)" ::: "memory"); else asm volatile("s_waitcnt vmcnt(0) lgkmcnt(0)" ::: "memory"); \
        __builtin_amdgcn_s_barrier(); asm volatile("" ::: "memory"); } while (0)
    f32x4 S[8];
#pragma unroll
    for (int dt = 0; dt < 8; ++dt) S[dt] = (f32x4){0.f, 0.f, 0.f, 0.f};
    const int dvc = half * 64 + (wave & 3) * 16 + fr;
    unsigned long long ucp[4];
#define REG_LOAD(n) do { const unsigned char* s_hd = IMGHD_OF(n); \
        _Pragma("unroll") for (int it_ = 0; it_ < 4; ++it_) ucp[it_] = *(const unsigned long long*)(s_hd + ID_UT + dvc * 128 + (it_ * 16 + qd * 4) * 2); } while (0)
    constexpr int OSTG = 2 * SB_BYTES + 1024;
#define OST_STORE(nprev, sb) do { if ((nprev) >= 4) { u16* orow_ = O + ((size_t)dir * NT + (size_t)b * L + (size_t)((nprev) - 4) * 64) * 1024 + hv * 128 + half * 64; \
        _Pragma("unroll") for (int j_ = 0; j_ < 8; ++j_) { const int ix_ = lane + 64 * j_, row_ = ix_ >> 3, ch_ = ix_ & 7; \
            *(pg::u32x4*)(orow_ + (size_t)row_ * 1024 + ch_ * 8) = *(const LAS pg::u32x4*)(lds + OSTG + (sb) * 8192 + row_ * 128 + ch_ * 16); } } } while (0)
    DMA_STEP(CHUNK_OF(0), 0);
    if (cw) REG_LOAD(CHUNK_OF(0));
    STEP_BARRIER();
    const int sdef = dir ? 71 - (DEF_N0(b) + 3) : DEF_N0(b);
    for (int s = 0; s < 68; ++s) {
        const int n = CHUNK_OF(s), buf = s & 1;
        const LAS unsigned char* lb = lds + buf * SB_BYTES;
        f32x4 u[4];
#pragma unroll
        for (int it = 0; it < 4; ++it) {
            const unsigned lo = (unsigned)ucp[it], hi = (unsigned)(ucp[it] >> 32);
            u[it] = (f32x4){__uint_as_float(lo << 16), __uint_as_float(lo & 0xffff0000u), __uint_as_float(hi << 16), __uint_as_float(hi & 0xffff0000u)};
        }
        if (wave == 7 && s > 0) OST_STORE(CHUNK_OF(s - 1), (s - 1) & 1);
        if (s == sdef - 2) {
            if (wave == 7) {
                const unsigned* fl = (const unsigned*)c.ws + DEF_FLAG(b * 16 + hq);
                while ((__hip_atomic_load(fl, __ATOMIC_RELAXED, __HIP_MEMORY_SCOPE_AGENT) & __hip_atomic_load(fl + 64, __ATOMIC_RELAXED, __HIP_MEMORY_SCOPE_AGENT)
                        & __hip_atomic_load(fl + 128, __ATOMIC_RELAXED, __HIP_MEMORY_SCOPE_AGENT) & __hip_atomic_load(fl + 192, __ATOMIC_RELAXED, __HIP_MEMORY_SCOPE_AGENT)) == 0u) __builtin_amdgcn_s_sleep(2);
                __builtin_amdgcn_fence(__ATOMIC_ACQUIRE, "agent");
            }
        }
        if (s + 1 < 68) { const int n2 = CHUNK_OF(s + 1); DMA_STEP(n2, buf ^ 1); if (cw) REG_LOAD(n2); }
        if (cw) {
#define SBAR __builtin_amdgcn_sched_barrier(0)
#define LD_ROWS4(dst, base, rt0) do { _Pragma("unroll") for (int r_ = 0; r_ < 2; ++r_) _Pragma("unroll") for (int ks_ = 0; ks_ < 4; ++ks_) \
            dst[r_ * 4 + ks_] = frag_perm(lb + (base) + (((rt0) + r_) * 16 + fr) * 272 + (ks_ * 32 + qd * 4) * 2); } while (0)
#define LD_ROWS2(dst, base, rt0) do { _Pragma("unroll") for (int r_ = 0; r_ < 4; ++r_) _Pragma("unroll") for (int ks_ = 0; ks_ < 2; ++ks_) \
            dst[r_ * 2 + ks_] = frag_perm(lb + (base) + (((rt0) + r_) * 16 + fr) * 144 + (ks_ * 32 + qd * 4) * 2); } while (0)
        const LAS float* gb = (const LAS float*)(lb + SB_G);
        bf16x8 sf[4], fa[8], fb[8], fc[8];
#pragma unroll
        for (int ks = 0; ks < 4; ++ks) sf[ks] = pack8(S[2 * ks], S[2 * ks + 1]);
        f32x4 o[4];
        LD_ROWS4(fa, SB_W, 0);
        LD_ROWS4(fb, SB_W, 2);
        SBAR;
        LD_ROWS4(fc, SB_Q, 0);
#pragma unroll
        for (int r = 0; r < 2; ++r)
#pragma unroll
            for (int ks = 0; ks < 4; ++ks) u[r] = mfma16(fa[r * 4 + ks], sf[ks], u[r]);
        SBAR;
        LD_ROWS4(fa, SB_Q, 2);
#pragma unroll
        for (int r = 0; r < 2; ++r)
#pragma unroll
            for (int ks = 0; ks < 4; ++ks) u[2 + r] = mfma16(fb[r * 4 + ks], sf[ks], u[2 + r]);
        SBAR;
        LD_ROWS2(fb, SB_QK, 0);
#pragma unroll
        for (int r = 0; r < 2; ++r) { o[r] = (f32x4){0.f, 0.f, 0.f, 0.f};
#pragma unroll
            for (int ks = 0; ks < 4; ++ks) o[r] = mfma16(fc[r * 4 + ks], sf[ks], o[r]); }
        bf16x8 uf[2], upf[2];
        {
            f32x4 ek[4];
#pragma unroll
            for (int it = 0; it < 4; ++it) ek[it] = *(const LAS f32x4*)(gb + 64 + it * 16 + qd * 4);
#pragma unroll
            for (int ks = 0; ks < 2; ++ks) { uf[ks] = pack8(u[2 * ks], u[2 * ks + 1]); upf[ks] = pack8(u[2 * ks] * ek[2 * ks], u[2 * ks + 1] * ek[2 * ks + 1]); }
        }
        SBAR;
        LD_ROWS2(fc, SB_KT, 0);
#pragma unroll
        for (int r = 0; r < 2; ++r) { o[2 + r] = (f32x4){0.f, 0.f, 0.f, 0.f};
#pragma unroll
            for (int ks = 0; ks < 4; ++ks) o[2 + r] = mfma16(fa[r * 4 + ks], sf[ks], o[2 + r]); }
        SBAR;
        const float ege = gb[128];
        LD_ROWS2(fa, SB_KT, 4);
#pragma unroll
        for (int it = 0; it < 4; ++it) { o[it] *= *(const LAS f32x4*)(gb + it * 16 + qd * 4);
#pragma unroll
            for (int ks = 0; ks < 2; ++ks) o[it] = mfma16(fb[it * 2 + ks], uf[ks], o[it]); }
        SBAR;
#pragma unroll
        for (int dt = 0; dt < 4; ++dt) { S[dt] *= ege;
#pragma unroll
            for (int ks = 0; ks < 2; ++ks) S[dt] = mfma16(fc[dt * 2 + ks], upf[ks], S[dt]); }
        SBAR;
#pragma unroll
        for (int dt = 0; dt < 4; ++dt) { S[4 + dt] *= ege;
#pragma unroll
            for (int ks = 0; ks < 2; ++ks) S[4 + dt] = mfma16(fa[dt * 2 + ks], upf[ks], S[4 + dt]); }
#undef SBAR
#undef LD_ROWS4
#undef LD_ROWS2
        if (n >= 4) {
            LAS unsigned char* sg = lds + OSTG + (s & 1) * 8192 + ((wave & 3) * 16 + fr) * 2;
#pragma unroll
            for (int it = 0; it < 4; ++it)
#pragma unroll
                for (int r = 0; r < 4; ++r) *(LAS u16*)(sg + (it * 16 + qd * 4 + r) * 128) = f2bf(o[it][r]);
        }
        }
        STEP_BARRIER();
    }
    if (wave == 7) OST_STORE(CHUNK_OF(67), 67 & 1);
    asm volatile("s_waitcnt vmcnt(0)" ::: "memory");
#undef CHUNK_OF
#undef IMGH_OF
#undef IMGHD_OF
#undef DMA_STEP
#undef REG_LOAD
#undef OST_STORE
#undef STEP_BARRIER
}

DI void ph_mergeprep2(const Ctx& c, const Blk& B) {
    const u16* O = (const u16*)(c.ws + WS_O2); const u16* SZ = (const u16*)(c.ws + WS_SZ); u16* OB = (u16*)(c.ws + WS_OB);
    for (int row = B.bid * 8 + B.wave; row < NT; row += B.G * 8) {
        const int c0 = B.lane * 16;
        const uint4 a0 = *(const uint4*)(O + (size_t)row * 1024 + c0), a1 = *(const uint4*)(O + (size_t)row * 1024 + c0 + 8);
        const uint4 b0 = *(const uint4*)(O + ((size_t)NT + row) * 1024 + c0), b1 = *(const uint4*)(O + ((size_t)NT + row) * 1024 + c0 + 8);
        const uint4 z0 = *(const uint4*)(SZ + (size_t)row * 1024 + c0), z1 = *(const uint4*)(SZ + (size_t)row * 1024 + c0 + 8);
        const unsigned aw[8] = {a0.x, a0.y, a0.z, a0.w, a1.x, a1.y, a1.z, a1.w}, bw[8] = {b0.x, b0.y, b0.z, b0.w, b1.x, b1.y, b1.z, b1.w}, zw[8] = {z0.x, z0.y, z0.z, z0.w, z1.x, z1.y, z1.z, z1.w};
        float o[16]; float ss = 0.f;
#pragma unroll
        for (int i = 0; i < 8; ++i) { o[2 * i] = __uint_as_float(aw[i] << 16) + __uint_as_float(bw[i] << 16); o[2 * i + 1] = __uint_as_float(aw[i] & 0xffff0000u) + __uint_as_float(bw[i] & 0xffff0000u); ss += o[2 * i] * o[2 * i] + o[2 * i + 1] * o[2 * i + 1]; }
#ifdef DBG_SANITIZE
        ss = 0.f;
#pragma unroll
        for (int i = 0; i < 16; ++i) { if (!(fabsf(o[i]) < 1e30f)) o[i] = 0.f; ss += o[i] * o[i]; }
#endif
        ss += __shfl_xor(ss, 1); ss += __shfl_xor(ss, 2); ss += __shfl_xor(ss, 4);
        const float rs = rsqrtf(ss * (1.f / 128.f) + EPS);
        unsigned ow[8];
#pragma unroll
        for (int i = 0; i < 8; ++i) { const int ch = (c0 + 2 * i) & 127;
            ow[i] = pg::cvt_pk_bf16(o[2 * i] * rs * c.gdn_norm_g[ch] * __uint_as_float(zw[i] << 16), o[2 * i + 1] * rs * c.gdn_norm_g[ch + 1] * __uint_as_float(zw[i] & 0xffff0000u)); }
        *(uint4*)(OB + (size_t)row * 1024 + c0) = make_uint4(ow[0], ow[1], ow[2], ow[3]); *(uint4*)(OB + (size_t)row * 1024 + c0 + 8) = make_uint4(ow[4], ow[5], ow[6], ow[7]);
    }
}

constexpr size_t WS_WRT = WS_MOD + 256 * 1024;
constexpr size_t WS_RC = WS_MOD + 128 * 1024;
DI void ph_router_const(const Ctx& c, const Blk& B) {
    if (B.bid >= 16) {
        if (B.bid < 80) {
            float* WRT = (float*)(c.ws + WS_WRT);
#pragma unroll
            for (int j = 0; j < 4; ++j) { const int idx = (B.bid - 16) * 512 + B.tid + 32768 * j, b = idx >> 15, k = (idx >> 5) & 1023, e = idx & 31;
                WRT[(size_t)(b * 32 + e) * 1024 + k] = c.w_router[k * 32 + e] * (c.norm2_g[k] * (1.f + ((const float*)(c.ws + WS_MOD))[b * 6144 + 4096 + k])); }
        }
        return;
    }
    const int idx = B.bid * 8 + B.wave, b = idx >> 5, e = idx & 31;
    const float* sh = (const float*)(c.ws + WS_MOD) + b * 6144 + 3072;
    float s = 0.f;
#pragma unroll 4
    for (int j = 0; j < 16; ++j) { const int k = B.lane + 64 * j; s += sh[k] * c.w_router[(size_t)k * 32 + e]; }
    s = wave_sum(s);
    if (B.lane == 0) ((float*)(c.ws + WS_RC))[idx] = s + c.b_router[e];
}
DI void ph_router_fast(const Ctx& c, const Blk& B, unsigned char* lds_raw) {
    const float* X1 = c.out; const float* MOD = (const float*)(c.ws + WS_MOD); u16* H2 = (u16*)(c.ws + WS_H2); const float* SSP = (const float*)(c.ws + WS_SSP);
    int* cnt = (int*)(c.ws + WS_CTL); int* TOKE = (int*)(c.ws + WS_TOKE); float* WTE = (float*)(c.ws + WS_WTE); int* TOPE = (int*)(c.ws + WS_TOPE); int* TOPP = (int*)(c.ws + WS_TOPP);
    LAS unsigned* arr = (LAS unsigned*)((LAS unsigned char*)lds_raw + 133120);
    const int lane = B.lane, i = lane & 15, kq = lane >> 4;
    for (int tb = B.bid; tb < NT / 64; tb += B.G) {
        __syncthreads();
        if (B.tid < 4) arr[B.tid] = 0u;
        __syncthreads();
        const int tok0 = tb * 64, b = tok0 / L;
        const float* g2 = c.norm2_g; const float* sh = MOD + b * 6144 + 3072; const float* sc = MOD + b * 6144 + 4096;
        if (B.wave >= 4) {
            const int r0 = tok0 + (B.wave - 4) * 16;
            f32x4 G[4], S[4];
#pragma unroll
            for (int j = 0; j < 4; ++j) { const f32x4 g = *(const f32x4*)(g2 + (lane + 64 * j) * 4), s = *(const f32x4*)(sc + (lane + 64 * j) * 4); G[j] = g * (s + 1.f); S[j] = *(const f32x4*)(sh + (lane + 64 * j) * 4); }
            float rsd;
            { const float* sp = SSP + (size_t)(4 * kq) * NT + r0 + i; float ssv = ((sp[0] + sp[NT]) + sp[2 * NT]) + sp[3 * NT];
              ssv += __shfl_xor(ssv, 16); ssv += __shfl_xor(ssv, 32); rsd = rsqrtf(ssv * (1.f / D) + EPS); }
#pragma unroll
            for (int rb = 0; rb < 16; rb += 8) {
                f32x4 v[8][4];
#pragma unroll
                for (int r = 0; r < 8; ++r)
#pragma unroll
                    for (int j = 0; j < 4; ++j) v[r][j] = *(const f32x4*)(X1 + (size_t)(r0 + rb + r) * D + (lane + 64 * j) * 4);
#pragma unroll
                for (int r = 0; r < 8; ++r) {
                    const float rstd = __builtin_bit_cast(float, __builtin_amdgcn_readlane(__builtin_bit_cast(int, rsd), rb + r));
#pragma unroll
                    for (int j = 0; j < 4; ++j) *(unsigned long long*)(H2 + (size_t)(r0 + rb + r) * D + (lane + 64 * j) * 4) = pack4(v[r][j] * rstd * G[j] + S[j]);
                }
            }
            continue;
        }
        const int w = B.wave, ks = w * 256;
        LAS float* xs = (LAS float*)lds_raw + w * 4160;
        LAS unsigned* hist = (LAS unsigned*)(xs + 3760);
        if (lane < 32) hist[lane] = 0u;
        float wa[64], wb[64];
        { const float* wt = (const float*)(c.ws + WS_WRT) + (size_t)(b * 32 + i) * 1024 + ks + 16 * kq;
#pragma unroll
          for (int c4 = 0; c4 < 4; ++c4)
#pragma unroll
            for (int s4 = 0; s4 < 4; ++s4) {
                const float4 A = *(const float4*)(wt + 64 * c4 + 4 * s4), Bv = *(const float4*)(wt + 16 * 1024 + 64 * c4 + 4 * s4);
                const int o = (c4 * 4 + s4) * 4;
                wa[o] = A.x; wa[o + 1] = A.y; wa[o + 2] = A.z; wa[o + 3] = A.w; wb[o] = Bv.x; wb[o + 1] = Bv.y; wb[o + 2] = Bv.z; wb[o + 3] = Bv.w;
            } }
        const float* xu = X1 + (size_t)tok0 * D + ks;
        const int lo = (lane >> 4) * D + (lane & 15) * 4;
        constexpr int NPF = 2;
        f32x4 xr[NPF][4];
#pragma unroll
        for (int p = 0; p < NPF; ++p)
#pragma unroll
            for (int t = 0; t < 4; ++t) xr[p][t] = *(const f32x4*)(xu + ((16 * (p >> 2) + 4 * t) * D + 64 * (p & 3)) + lo);
        f32x4 a0 = (f32x4){0.f, 0.f, 0.f, 0.f}, a1 = (f32x4){0.f, 0.f, 0.f, 0.f};
#pragma unroll
        for (int p = 0; p < 16; ++p) {
            const int g = p >> 2, c4 = p & 3;
#pragma unroll
            for (int t = 0; t < 4; ++t) *(LAS f32x4*)(xs + (4 * t + (lane >> 4)) * 68 + (lane & 15) * 4) = xr[p % NPF][t];
            if (p + NPF < 16) {
#pragma unroll
                for (int t = 0; t < 4; ++t) xr[p % NPF][t] = *(const f32x4*)(xu + ((16 * ((p + NPF) >> 2) + 4 * t) * D + 64 * ((p + NPF) & 3)) + lo);
            }
            asm volatile("s_waitcnt lgkmcnt(0)" ::: "memory");
#pragma unroll
            for (int s4 = 0; s4 < 4; ++s4) {
                const f32x4 v = *(const LAS f32x4*)(xs + i * 68 + kq * 16 + 4 * s4);
#pragma unroll
                for (int q = 0; q < 4; ++q) {
                    a0 = __builtin_amdgcn_mfma_f32_16x16x4f32(v[q], wa[(c4 * 4 + s4) * 4 + q], a0, 0, 0, 0);
                    a1 = __builtin_amdgcn_mfma_f32_16x16x4f32(v[q], wb[(c4 * 4 + s4) * 4 + q], a1, 0, 0, 0);
                }
            }
            asm volatile("" ::: "memory");
            if (c4 == 3) {
                LAS float* P = (LAS float*)lds_raw + g * 4160 + 1088 + w * 528;
#pragma unroll
                for (int r = 0; r < 4; ++r) { P[(4 * kq + r) * 33 + i] = a0[r]; P[(4 * kq + r) * 33 + 16 + i] = a1[r]; }
                asm volatile("s_waitcnt lgkmcnt(0)" ::: "memory");
                if (lane == 0) __hip_atomic_fetch_add(arr + g, 1u, __ATOMIC_RELEASE, __HIP_MEMORY_SCOPE_WORKGROUP);
                a0 = (f32x4){0.f, 0.f, 0.f, 0.f}; a1 = (f32x4){0.f, 0.f, 0.f, 0.f};
            }
        }
        while (__hip_atomic_load(arr + w, __ATOMIC_ACQUIRE, __HIP_MEMORY_SCOPE_WORKGROUP) < 4u) __builtin_amdgcn_s_sleep(1);
        asm volatile("s_waitcnt lgkmcnt(0)" ::: "memory");
        const int row0 = tok0 + 16 * w;
        float ssv;
        { const float* sp = SSP + (size_t)(4 * kq) * NT + row0 + i; ssv = ((sp[0] + sp[NT]) + sp[2 * NT]) + sp[3 * NT]; }
        ssv += __shfl_xor(ssv, 16); ssv += __shfl_xor(ssv, 32);
        const float rstd = rsqrtf(ssv * (1.f / D) + EPS);
        LAS float* Pm = xs + 1088;
        LAS float* lg = xs + 3200;
        const float* RC = (const float*)(c.ws + WS_RC) + b * 32;
#pragma unroll
        for (int e8 = 0; e8 < 8; ++e8) { const int e = 8 * kq + e8, o = i * 33 + e;
            lg[i * 34 + e] = (((Pm[o] + Pm[528 + o]) + Pm[1056 + o]) + Pm[1584 + o]) * rstd + RC[e]; }
        asm volatile("s_waitcnt lgkmcnt(0)" ::: "memory");
        int sidx[4] = {0, 0, 0, 0}, slp[4] = {0, 0, 0, 0}, strow = 0; float sw[4] = {0.f, 0.f, 0.f, 0.f};
        if (B.lane < 16) {
            float l_[32];
#pragma unroll
            for (int e = 0; e < 32; e += 2) { const pg::f32x2_ t = *(const LAS pg::f32x2_*)(lg + B.lane * 34 + e); l_[e] = t[0]; l_[e + 1] = t[1]; }
            int idx[4]; float val[4];
#pragma unroll
            for (int j = 0; j < 4; ++j) {
                float best = -3.0e38f; int bi = 0;
#pragma unroll
                for (int e = 0; e < 32; ++e) { const bool taken = (j > 0 && idx[0] == e) || (j > 1 && idx[1] == e) || (j > 2 && idx[2] == e); if (!taken && l_[e] > best) { best = l_[e]; bi = e; } }
                idx[j] = bi; val[j] = best;
            }
            float wv[4], den = 0.f;
#pragma unroll
            for (int j = 0; j < 4; ++j) { wv[j] = expf(val[j] - val[0]); den += wv[j]; }
            int lp[4];
#pragma unroll
            for (int j = 0; j < 4; ++j) lp[j] = (int)__hip_atomic_fetch_add((LAS unsigned*)hist + idx[j], 1u, __ATOMIC_RELAXED, __HIP_MEMORY_SCOPE_WORKGROUP);
            asm volatile("s_waitcnt lgkmcnt(0)" ::: "memory");
            sidx[0] = idx[0]; sidx[1] = idx[1]; sidx[2] = idx[2]; sidx[3] = idx[3]; slp[0] = lp[0]; slp[1] = lp[1]; slp[2] = lp[2]; slp[3] = lp[3];
            sw[0] = wv[0] / den; sw[1] = wv[1] / den; sw[2] = wv[2] / den; sw[3] = wv[3] / den; strow = row0 + B.lane;
        }
        asm volatile("s_waitcnt lgkmcnt(0)" ::: "memory");
        if (B.lane < 32) { const unsigned n = hist[B.lane]; unsigned base = 0u; if (n) base = (unsigned)atomicAdd(&cnt[64 * B.lane], (int)n); hist[32 + B.lane] = base; }
        asm volatile("s_waitcnt vmcnt(0) lgkmcnt(0)" ::: "memory");
        if (B.lane < 16) {
#pragma unroll
            for (int j = 0; j < 4; ++j) {
                const int e = sidx[j]; const int pos = (int)hist[32 + e] + slp[j];
                TOKE[e * CAP + pos] = strow; WTE[e * CAP + pos] = sw[j]; TOPE[strow * 4 + j] = e; TOPP[strow * 4 + j] = pos;
            }
        }
        asm volatile("s_waitcnt lgkmcnt(0)" ::: "memory");
    }
}


DI void ph_dftm2(const Ctx& c, const Blk& B, float* lds) {
    u16* CS = (u16*)c.out;
    float* tab = lds + 8192;
    __syncthreads();
    for (int i = B.tid; i < 4096; i += 512) tab[i] = cospif((float)i * (1.f / 2048.f));
    __syncthreads();
    const size_t n8 = (size_t)2 * 2048 * 2048 / 8;
    for (size_t i = (size_t)B.bid * 512 + B.tid; i < n8; i += (size_t)B.G * 512) {
        const int which = (int)(i >> 19), r = (int)(i & 524287), k = r >> 8, l0 = (r & 255) * 8, ph = which ? 3072 : 0;
        unsigned w[4];
#pragma unroll
        for (int q = 0; q < 4; ++q) {
            const float lo = tab[((k * (l0 + 2 * q)) + ph) & 4095], hi = tab[((k * (l0 + 2 * q + 1)) + ph) & 4095];
            w[q] = (unsigned)f2bf(lo) | ((unsigned)f2bf(hi) << 16);
        }
        *(uint4*)(CS + i * 8) = make_uint4(w[0], w[1], w[2], w[3]);
    }
    __syncthreads();
}
DI void ph_dft_edge(const Ctx& c, const Blk& B) {
    const u16* WFT = (const u16*)(c.ws + WS_WFT); const u16* FE = (const u16*)((const char*)c.out + FE_OUT_OFF); float* NYQ = (float*)(c.ws + WS_NYQ);
    for (int n = B.bid * 8 + B.wave; n < 2048; n += B.G * 8) {
        const int b = n >> 9, gm = n & 511;
        const u16* ur = (const u16*)(c.ws + WS_NYQ + 16384) + (size_t)b * D; const u16* wr = WFT + (size_t)gm * D;
        float f = 0.f, nyq = 0.f;
#pragma unroll
        for (int j = 0; j < 2; ++j) {
            const uint4 a = *(const uint4*)(ur + (B.lane + 64 * j) * 8), w = *(const uint4*)(wr + (B.lane + 64 * j) * 8);
            const unsigned aw[4] = {a.x, a.y, a.z, a.w}, ww[4] = {w.x, w.y, w.z, w.w};
#pragma unroll
            for (int q = 0; q < 4; ++q) f += __uint_as_float(aw[q] << 16) * __uint_as_float(ww[q] << 16) + __uint_as_float(aw[q] & 0xffff0000u) * __uint_as_float(ww[q] & 0xffff0000u);
        }
#pragma unroll
        for (int j = 0; j < 4; ++j) {
            const uint4 e = *(const uint4*)(FE + (size_t)n * 4096 + (B.lane + 64 * j) * 8);
            const unsigned ew[4] = {e.x, e.y, e.z, e.w};
#pragma unroll
            for (int q = 0; q < 4; ++q) nyq += __uint_as_float(ew[q] << 16) - __uint_as_float(ew[q] & 0xffff0000u);
        }
        f = wave_sum(f); nyq = wave_sum(nyq);
        if (B.lane == 0) { NYQ[n] = nyq + f; NYQ[2048 + n] = f; }
    }
}
struct SchedDFT2 {
    const char* CS; const char* FE; int c, first;
    DI bool next(int i, pg::Unit& u) const {
        const int me = c - first; if (i != 0 || me < 0 || me >= 128) return false;
        const int kind = me >> 6, idx = me & 63;
        u.pm = idx >> 3; u.pn = idx & 7; u.kind = kind; u.ex = 0; u.nt = 32;
        const char* a = CS + (size_t)kind * 2048 * 4096 + (size_t)u.pm * 256 * 4096; const char* b = FE + (size_t)u.pn * 256 * 8192 + (size_t)kind * 4096;
        u.a0 = a; u.a1 = a + 128 * 4096; u.b0 = b; u.b1 = b + 128 * 8192; u.v00 = u.v01 = u.v10 = u.v11 = 0u;
        return true;
    }
};
struct EpiDFT2 {
    float* PCS;
    DI void operator()(const pg::f32x4 (&acc)[2][2][4][2], const pg::Unit& u, int wr, int wc, int fr, int fq) const {
        float* base = PCS + (size_t)u.kind * 2048 * 2048 + (size_t)u.pm * 256 * 2048 + u.pn * 256 + wc * 32 + 4 * fq;
#pragma unroll
        for (int ai = 0; ai < 2; ++ai)
#pragma unroll
            for (int m = 0; m < 4; ++m) { float* rowp = base + (size_t)(ai * 128 + wr * 64 + m * 16 + fr) * 2048;
#pragma unroll
                for (int bj = 0; bj < 2; ++bj)
#pragma unroll
                    for (int n = 0; n < 2; ++n) *(pg::f32x4*)(rowp + bj * 128 + n * 16) = acc[ai][bj][m][n]; }
    }
};
DI void ph_dft2(const Ctx& c, const Blk& B, unsigned char* lds_raw, int first) {
    SchedDFT2 S{(const char*)c.out, (const char*)c.out + FE_OUT_OFF, B.bid, first};
    EpiDFT2 E{(float*)((char*)c.out + 16 * MiB)};
    pg::gemm_phase<false, false>((LAS unsigned char*)lds_raw, B.tid, 2048, 4096, S, E);
}
DI void ph_dft_combine(const Ctx& c, const Blk& B) {
    const float* PC = (const float*)((const char*)c.out + 16 * MiB); const float* PS = PC + (size_t)2048 * 2048; const float* NYQ = (const float*)(c.ws + WS_NYQ);
    u16* FM = (u16*)(c.ws + WS_FM2);
    const float scale = 1.f / 724.0773439350247f;
    for (int task = B.bid * 8 + B.wave; task < 4 * 2049; task += B.G * 8) {
        const int b = task / 2049, kk = task % 2049, n0 = b * 512 + B.lane * 8;
        float y0[8], y1[8];
        if (kk == 2048) {
#pragma unroll
            for (int j = 0; j < 8; ++j) y0[j] = NYQ[n0 + j];
        } else {
            const float sg = (kk & 1) ? -1.f : 1.f;
#pragma unroll
            for (int h = 0; h < 2; ++h) {
                const float4 pc = *(const float4*)(PC + (size_t)kk * 2048 + n0 + 4 * h), ps = *(const float4*)(PS + (size_t)kk * 2048 + n0 + 4 * h), f = *(const float4*)(NYQ + 2048 + n0 + 4 * h);
                const float pcv[4] = {pc.x, pc.y, pc.z, pc.w}, psv[4] = {ps.x, ps.y, ps.z, ps.w}, fv[4] = {f.x, f.y, f.z, f.w};
#pragma unroll
                for (int j = 0; j < 4; ++j) { const float base = pcv[j] + sg * fv[j]; y0[4 * h + j] = base - psv[j]; y1[4 * h + j] = base + psv[j]; }
            }
        }
        *(uint4*)(FM + ((size_t)b * 4096 + kk) * 512 + B.lane * 8) = make_uint4(pg::cvt_pk_bf16(y0[0] * scale, y0[1] * scale), pg::cvt_pk_bf16(y0[2] * scale, y0[3] * scale), pg::cvt_pk_bf16(y0[4] * scale, y0[5] * scale), pg::cvt_pk_bf16(y0[6] * scale, y0[7] * scale));
        if (kk >= 1 && kk <= 2047)
            *(uint4*)(FM + ((size_t)b * 4096 + (4096 - kk)) * 512 + B.lane * 8) = make_uint4(pg::cvt_pk_bf16(y1[0] * scale, y1[1] * scale), pg::cvt_pk_bf16(y1[2] * scale, y1[3] * scale), pg::cvt_pk_bf16(y1[4] * scale, y1[5] * scale), pg::cvt_pk_bf16(y1[6] * scale, y1[7] * scale));
    }
}

#define XB_TMO      128
#define XB_XCNT(j)  (256  + 64 * (j))
#define XB_XSUB(j)  (1280 + 64 * (j))
#define XB_XGEN(j)  (2304 + 64 * (j))
#define XB_TOP      3328
#define XB_TOPGEN   3392
#define XB_SPIN_CAP (1u << 18)
constexpr int XB_BASE = 8192;
constexpr int XB_LDS_OFF = 147456;
DI unsigned xb_ld(unsigned* p)              { return __hip_atomic_load(p, __ATOMIC_RELAXED, __HIP_MEMORY_SCOPE_AGENT); }
DI unsigned xb_add(unsigned* p, unsigned v) { return __hip_atomic_fetch_add(p, v, __ATOMIC_RELAXED, __HIP_MEMORY_SCOPE_AGENT); }
DI unsigned xb_xcc_id() { return (unsigned)__builtin_amdgcn_s_getreg((3 << 11) | 20) & 0xFu; }
#define XB_SPIN(cond, bar) do { unsigned _sp = 0; while (cond) { __builtin_amdgcn_s_sleep(1); \
    if ((++_sp & 255u) == 0u) { if (xb_ld(&(bar)[XB_TMO])) break; if (_sp > XB_SPIN_CAP) { atomicAdd(&(bar)[XB_TMO], 1u); break; } } } } while (0)
DI void xcd_barrier_complete(unsigned* bar, unsigned x, unsigned& nloc, unsigned& nx) {
    const unsigned G = gridDim.x;
    unsigned sum, cnt, mine, sp = 0u;
    for (;;) {
        sum = 0u; cnt = 0u; mine = 0u;
#pragma unroll
        for (unsigned j = 0; j < 16; ++j) { const unsigned c = xb_ld(&bar[XB_XCNT(j)]); sum += c; cnt += (c > 0u) ? 1u : 0u; mine = (j == x) ? c : mine; }
        if (sum == G) break;
        __builtin_amdgcn_s_sleep(1);
        if ((++sp & 255u) == 0u) { if (xb_ld(&bar[XB_TMO])) break; if (sp > XB_SPIN_CAP) { atomicAdd(&bar[XB_TMO], 1u); break; } }
    }
    nloc = mine > 0u ? mine : 1u; nx = cnt > 0u ? cnt : 1u;
}
DI void xcd_barrier(unsigned* bar, volatile LAS unsigned* st, int tid) {
    asm volatile("s_waitcnt vmcnt(0)" ::: "memory");
    __syncthreads();
    if (tid == 0) {
        const unsigned x = xb_xcc_id();
        __builtin_amdgcn_s_waitcnt(0);
        unsigned nloc = st[0], nx = st[1];
        if (nloc == 0u) { xcd_barrier_complete(bar, x, nloc, nx); st[0] = nloc; st[1] = nx; }
        const unsigned old = xb_add(&bar[XB_XSUB(x)], 1u);
        const unsigned gen = old / nloc;
        if (old + 1u == (gen + 1u) * nloc) {
            __builtin_amdgcn_fence(__ATOMIC_RELEASE, "agent");
            asm volatile("s_waitcnt vmcnt(0)" ::: "memory");
            const unsigned og = xb_add(&bar[XB_TOP], 1u);
            const unsigned tg = og / nx;
            if (og + 1u == (tg + 1u) * nx) xb_add(&bar[XB_TOPGEN], 1u);
            else XB_SPIN(xb_ld(&bar[XB_TOPGEN]) == tg, bar);
            __builtin_amdgcn_fence(__ATOMIC_ACQUIRE, "agent");
            xb_add(&bar[XB_XGEN(x)], 1u);
            asm volatile("s_waitcnt vmcnt(0)" ::: "memory");
        } else {
            XB_SPIN(xb_ld(&bar[XB_XGEN(x)]) == gen, bar);
            __builtin_amdgcn_fence(__ATOMIC_ACQUIRE, "agent");
            asm volatile("s_waitcnt vmcnt(0)" ::: "memory");
        }
    }
    __syncthreads();
}

constexpr int LDS_BYTES = 147456 + 256;
__global__ void __launch_bounds__(512, 2) mega(Ctx carg) {
    extern __shared__ __attribute__((aligned(16))) unsigned char lds_raw[];
    float* lds = (float*)lds_raw;
    const int wv0 = __builtin_amdgcn_readfirstlane((int)threadIdx.x >> 6);
#define WSP(T, off) ((T*)(c.ws + (off)))
    {
        volatile LAS unsigned* st = (volatile LAS unsigned*)((LAS unsigned char*)lds_raw + XB_LDS_OFF);
        if (threadIdx.x < 4) st[threadIdx.x] = 0u;
        __syncthreads();
        if (threadIdx.x == 0) { const Ctx& c = ctx(); (void)xb_add((unsigned*)c.ws + XB_BASE + XB_XCNT(xb_xcc_id()), 1u); }
    }
#define GSYNC() do { const Ctx& c_ = ctx(); const Blk B_ = mkblk(wv0); xcd_barrier((unsigned*)c_.ws + XB_BASE, (volatile LAS unsigned*)((LAS unsigned char*)lds_raw + XB_LDS_OFF), B_.tid); } while (0)

    { const Ctx& c = ctx(); const Blk B = mkblk(wv0); ph_mod(c, B, lds); ph_dftm2(c, B, lds); }
    { const Ctx& c = ctx(); const Blk B = mkblk(wv0); ph_wprep_small(c, B, lds); ph_wprep_fourier(c, B, lds); }
    { const Ctx& c = ctx(); const Blk B = mkblk(wv0); wait_mod(c, B); }
    { const Ctx& c = ctx(); const Blk B = mkblk(wv0); ph_router_const(c, B); ph_u(c, B); }
    GSYNC();
    { const Ctx& c = ctx(); const Blk B = mkblk(wv0); ph_gemm1(c, B, lds_raw); }
    GSYNC();
    { const Ctx& c = ctx(); const Blk B = mkblk(wv0); ph_dft_edge(c, B); ph_gdn_prep(c, B, lds_raw, 0); }
    GSYNC();
    { const Ctx& c = ctx(); const Blk B = mkblk(wv0); ph_gdn_scan(c, B, lds_raw, 0); if (B.bid >= 128) { ph_gdn_prep(c, B, lds_raw, 1); __syncthreads(); } ph_dft2(c, B, lds_raw, 128); if (B.bid >= 128) wprep_gate_queue(c, B, lds_raw); }
    GSYNC();
    { const Ctx& c = ctx(); const Blk B = mkblk(wv0); ph_dft_combine(c, B); ph_mergeprep2(c, B); }
    GSYNC();
    { const Ctx& c = ctx(); const Blk B = mkblk(wv0); ph_merge_ab(c, B, lds_raw); }
    GSYNC();
    { const Ctx& c = ctx(); const Blk B = mkblk(wv0); ph_merge_c(c, B, lds_raw); }
    GSYNC();
    { const Ctx& c = ctx(); const Blk B = mkblk(wv0); ph_router_fast(c, B, lds_raw); }
    { const Ctx& c = ctx(); const Blk B = mkblk(wv0); ph_wprep_moe(c, B, lds); }
    GSYNC();
    { const Ctx& c = ctx(); const Blk B = mkblk(wv0); ph_moe_gu(c, B, lds_raw); wprep_down_queue(c, B, lds_raw); }
    GSYNC();
    { const Ctx& c = ctx(); const Blk B = mkblk(wv0); ph_moe_down(c, B, lds_raw); }
    GSYNC();
    { const Ctx& c = ctx(); const Blk B = mkblk(wv0); ph_final(c, B, lds); }
}

extern "C" void kernel_launch(void* const* d_in, const int* in_sizes, int n_in, void* d_out, int out_size, void* d_ws, size_t ws_size, hipStream_t stream) {
    static int grid = 0;
    if (grid == 0) {
        if (n_in != 25 || ws_size < (size_t)512 * MiB || out_size != NT * D) { fprintf(stderr, "kernel_launch: unexpected sizes n_in %d ws %zu (need %zu) out %d\n", n_in, ws_size, (size_t)WS_NEED, out_size); grid = -1; return; }
        int dev = 0, cus = 0, per_cu = 0;
        if (hipGetDevice(&dev) != hipSuccess || hipDeviceGetAttribute(&cus, hipDeviceAttributeMultiprocessorCount, dev) != hipSuccess) { grid = -1; return; }
        if (hipFuncSetAttribute((const void*)mega, hipFuncAttributeMaxDynamicSharedMemorySize, LDS_BYTES) != hipSuccess) { fprintf(stderr, "kernel_launch: hipFuncSetAttribute failed\n"); grid = -1; return; }
        if (hipOccupancyMaxActiveBlocksPerMultiprocessor(&per_cu, (const void*)mega, 512, LDS_BYTES) != hipSuccess || per_cu < 1) { fprintf(stderr, "kernel_launch: occupancy query failed (%d)\n", per_cu); (void)hipGetLastError(); per_cu = 1; }
        grid = cus * 1;
        fprintf(stderr, "kernel_launch: cus %d per_cu %d grid %d ws %zu\n", cus, per_cu, grid, ws_size);
    }
    if (grid < 0) return;
    (void)hipMemsetAsync((char*)d_ws + WS_CTL, 0, 1 * MiB, stream);
    Ctx c{};
    const float** p = (const float**)&c;
    for (int i = 0; i < 25; ++i) p[i] = (const float*)d_in[i];
    c.out = (float*)d_out; c.ws = (char*)d_ws;
    void* args[] = {&c};
    hipError_t e = hipLaunchCooperativeKernel((const void*)mega, dim3(grid), dim3(512), args, LDS_BYTES, stream);
    if (e != hipSuccess) fprintf(stderr, "kernel_launch: cooperative launch failed: %s (grid %d)\n", hipGetErrorString(e), grid);
}
```

```cpp
#include <hip/hip_runtime.h>
#include <hip/hip_cooperative_groups.h>
#include <cstdio>
#include <cstdint>

typedef unsigned short u16;

constexpr int D = 1024, NB = 4, L = 4096, NT = NB * L, CT = 256, NC = NB * CT, MR = NT + NC;
constexpr int IN_COLS = 5664;
constexpr int NE = 32, CAP = 16384, SLOTS = 73728;
constexpr float EPS = 1e-6f;

constexpr size_t MiB = 1u << 20;
constexpr size_t WS_CTL = 0;
constexpr size_t WS_MOD = 1 * MiB;
constexpr size_t WS_TOPE = 2 * MiB;
constexpr size_t WS_TOPP = 3 * MiB;
constexpr size_t WS_TOKE = 4 * MiB;
constexpr size_t WS_WTE = 6 * MiB;
constexpr size_t WS_H2 = 8 * MiB;
constexpr size_t WS_B = 40 * MiB;
constexpr size_t WS_U = WS_B;
constexpr size_t WS_OB = WS_U;
constexpr size_t WS_QKV = WS_U + 34 * MiB;
constexpr size_t WS_T1 = WS_QKV;
constexpr size_t WS_BA = WS_QKV + 68 * MiB;
constexpr size_t WS_SZ = WS_BA + 3 * MiB;
constexpr size_t WS_GA = WS_SZ + 32 * MiB;
constexpr size_t WS_GB = WS_GA + 32 * MiB;
constexpr size_t WS_FB = WS_GB + 32 * MiB;
constexpr size_t WS_FT2 = WS_FB + 16 * MiB;
constexpr size_t WS_DFTM = WS_FT2 + 32 * MiB;
constexpr size_t WS_O = WS_DFTM;
constexpr size_t WS_FM = WS_DFTM + 64 * MiB;
constexpr size_t WS_QKVN = WS_FM + 16 * MiB;
constexpr size_t WS_M1 = WS_QKVN;
constexpr size_t WS_END_B = WS_QKVN + 68 * MiB;
constexpr size_t WS_ACT = WS_B;
constexpr size_t WS_Y = WS_B + 144 * MiB;
constexpr size_t WS_NEED = (WS_END_B > WS_Y + 144 * MiB) ? WS_END_B : (WS_Y + 144 * MiB);

__device__ __forceinline__ float bf2f(u16 v) { return __uint_as_float(((unsigned)v) << 16); }
__device__ __forceinline__ u16 f2bf(float f) { unsigned u = __float_as_uint(f); u += 0x7fffu + ((u >> 16) & 1u); return (u16)(u >> 16); }
__device__ __forceinline__ float sigmoidf_(float v) { return 1.f / (1.f + expf(-v)); }
__device__ __forceinline__ float siluf_(float v) { return v / (1.f + expf(-v)); }
__device__ __forceinline__ float softplusf_(float v) { return v > 20.f ? v : log1pf(expf(v)); }
__device__ __forceinline__ float wave_sum(float v) {
#pragma unroll
    for (int o = 1; o < 64; o <<= 1) v += __shfl_xor(v, o);
    return v;
}

namespace cg = cooperative_groups;
#define DI __device__ __forceinline__
constexpr size_t WS_FT2N = 458 * MiB;
constexpr size_t FE_OUT_OFF = 48 * MiB;
constexpr size_t WS_NYQ = 506 * MiB;
constexpr size_t WS_FM2 = 8 * MiB;
constexpr size_t WS_IMGH = 24 * MiB;
constexpr size_t WS_O2 = 74 * MiB;
constexpr size_t WS_IMGHD = 241 * MiB;
constexpr int IMGH_STRIDE = 35840, IMGHD_STRIDE = 44032;
constexpr int IH_Q = 0, IH_KT = 17408;
constexpr int ID_W = 0, ID_QK = 17408, ID_G = 26624, ID_UT = 27648;
static_assert(WS_IMGH + (size_t)1088 * IMGH_STRIDE <= 62 * MiB && WS_IMGHD + (size_t)4352 * IMGHD_STRIDE <= 424 * MiB, "gdn images");

struct Ctx {
    const float *x, *c, *ctx, *c_ctx, *w_mod, *b_mod, *norm1_g, *norm2_g, *w_in, *conv_w, *a_log, *dt_bias, *gdn_norm_g, *w_fo, *w_go, *w_mo,
                *w_router, *b_router, *w_gate, *b_gate, *w_up, *b_up, *w_down, *b_down, *final_g;
    float* out; char* ws;
};
struct Blk { int G, bid, tid, wave, lane; };
DI Blk mkblk(int wv) { int g = gridDim.x, bi = blockIdx.x; asm volatile("" : "+s"(wv), "+s"(g), "+s"(bi)); Blk B; B.G = g; B.bid = bi; B.wave = wv;
    int ln; asm volatile("v_mbcnt_lo_u32_b32 %0, -1, 0\n\tv_mbcnt_hi_u32_b32 %0, -1, %0" : "=v"(ln)); B.lane = ln; B.tid = wv * 64 + ln; return B; }
DI const Ctx& ctx() { const __attribute__((address_space(4))) char* p = (const __attribute__((address_space(4))) char*)__builtin_amdgcn_kernarg_segment_ptr(); asm volatile("" : "+s"(p)); return *(const Ctx*)(const char*)p; }

constexpr int MOD_FLAG = 2304;
DI void ph_mod(const Ctx& c, const Blk& B, float* lds) {
    float* s = lds;
    float* part = lds + 5 * 1024;
    float* MOD = (float*)(c.ws + WS_MOD);
    for (int i = B.tid; i < 5 * 1024; i += 512) { const int r = i >> 10, k = i & 1023; const float v = r < 4 ? c.c[r * 1024 + k] : c.c_ctx[k]; s[i] = siluf_(v); }
    __syncthreads();
    for (int item = B.bid; item < 96; item += B.G) {
        const int n = item * 64 + B.lane;
        float a0 = 0.f, a1 = 0.f, a2 = 0.f, a3 = 0.f, a4 = 0.f;
        const int k0 = B.wave * 128;
#pragma unroll 32
        for (int k = k0; k < k0 + 128; ++k) { const float w = c.w_mod[(size_t)k * 6144 + n]; a0 += s[k] * w; a1 += s[1024 + k] * w; a2 += s[2048 + k] * w; a3 += s[3072 + k] * w; a4 += s[4096 + k] * w; }
        float* p = part + B.wave * 320 + B.lane;
        p[0] = a0; p[64] = a1; p[128] = a2; p[192] = a3; p[256] = a4;
        __syncthreads();
        if (B.tid < 320) { const int r = B.tid >> 6, l = B.tid & 63; float t = 0.f;
#pragma unroll
            for (int w = 0; w < 8; ++w) t += part[w * 320 + r * 64 + l];
            MOD[r * 6144 + item * 64 + l] = t + c.b_mod[item * 64 + l]; }
        asm volatile("s_waitcnt vmcnt(0)" ::: "memory");
        __syncthreads();
        if (B.tid == 0) { __builtin_amdgcn_fence(__ATOMIC_RELEASE, "agent"); __hip_atomic_fetch_add((unsigned*)c.ws + MOD_FLAG, 1u, __ATOMIC_RELEASE, __HIP_MEMORY_SCOPE_AGENT); }
    }
}
DI void wait_mod(const Ctx& c, const Blk& B) {
    if (B.tid == 0) {
        while (__hip_atomic_load((unsigned*)c.ws + MOD_FLAG, __ATOMIC_RELAXED, __HIP_MEMORY_SCOPE_AGENT) < 96u) __builtin_amdgcn_s_sleep(2);
        __builtin_amdgcn_fence(__ATOMIC_ACQUIRE, "agent");
    }
    __syncthreads();
}
DI void u_row(const Ctx& c, const float* MOD, const float* src, int mr, int lane, float (&y)[16]) {
    float4 v[4]; float ss = 0.f;
#pragma unroll
    for (int j = 0; j < 4; ++j) { v[j] = ((const float4*)src)[lane + 64 * j]; ss += v[j].x * v[j].x + v[j].y * v[j].y + v[j].z * v[j].z + v[j].w * v[j].w; }
    ss = wave_sum(ss);
    const float rstd = rsqrtf(ss * (1.f / D) + EPS);
    const float* sh = MOD + mr * 6144; const float* sc = sh + 1024;
#pragma unroll
    for (int j = 0; j < 4; ++j) {
        const int k = (lane + 64 * j) * 4;
        const float4 g = *(const float4*)(c.norm1_g + k), s4 = *(const float4*)(sc + k), h4 = *(const float4*)(sh + k);
        y[4 * j] = v[j].x * rstd * g.x * (1.f + s4.x) + h4.x; y[4 * j + 1] = v[j].y * rstd * g.y * (1.f + s4.y) + h4.y;
        y[4 * j + 2] = v[j].z * rstd * g.z * (1.f + s4.z) + h4.z; y[4 * j + 3] = v[j].w * rstd * g.w * (1.f + s4.w) + h4.w;
    }
}
DI void u_store(u16* dst, int lane, const float (&y)[16]) {
#pragma unroll
    for (int j = 0; j < 4; ++j) { ushort4 o4; o4.x = f2bf(y[4 * j]); o4.y = f2bf(y[4 * j + 1]); o4.z = f2bf(y[4 * j + 2]); o4.w = f2bf(y[4 * j + 3]); *(ushort4*)(dst + (lane + 64 * j) * 4) = o4; }
}
DI void ph_u(const Ctx& c, const Blk& B) {
    const float* MOD = (const float*)(c.ws + WS_MOD); u16* U = (u16*)(c.ws + WS_U); u16* UE = (u16*)(c.ws + WS_FT2N); u16* UO = UE + (size_t)8192 * 1024;
    for (int task = B.bid * 8 + B.wave; task < 4 * 2049 + NC; task += B.G * 8) {
        float ya[16];
        if (task >= 4 * 2049) { const int row = NT + task - 4 * 2049; u_row(c, MOD, c.ctx + (size_t)(row - NT) * D, 4, B.lane, ya); u_store(U + (size_t)row * D, B.lane, ya); continue; }
        const int b = task / 2049, l = task % 2049, rowA = b * L + l;
        u_row(c, MOD, c.x + (size_t)rowA * D, b, B.lane, ya); u_store(U + (size_t)rowA * D, B.lane, ya);
        if (l == 2048) { u_store((u16*)(c.ws + WS_NYQ + 16384) + (size_t)b * D, B.lane, ya); continue; }
        float e[16], o[16];
        if (l >= 1) {
            float yb[16]; const int rowB = b * L + (L - l);
            u_row(c, MOD, c.x + (size_t)rowB * D, b, B.lane, yb); u_store(U + (size_t)rowB * D, B.lane, yb);
#pragma unroll
            for (int i = 0; i < 16; ++i) { e[i] = ya[i] + yb[i]; o[i] = ya[i] - yb[i]; }
        } else {
#pragma unroll
            for (int i = 0; i < 16; ++i) { e[i] = ya[i]; o[i] = 0.f; }
        }
        u_store(UE + (size_t)(b * 2048 + l) * D, B.lane, e); u_store(UO + (size_t)(b * 2048 + l) * D, B.lane, o);
    }
}

DI void moe_tables(const Ctx& c, const Blk& B, int* tab) {
    const int* cnt = (const int*)(c.ws + WS_CTL);
    __syncthreads();
    if (B.tid == 0) { int ts = 0, sb = 0; for (int e = 0; e < 32; ++e) { const int n = cnt[64 * e]; tab[e] = ts; tab[40 + e] = sb; tab[80 + e] = n; ts += ((n + 63) / 64) * 16; sb += (n + 255) & ~255; } tab[32] = ts; tab[72] = sb; }
    __syncthreads();
}
DI void ph_final(const Ctx& c, const Blk& B, float* lds) {
    int* tab = (int*)lds;
    moe_tables(c, B, tab);
    const u16* Y = (const u16*)(c.ws + WS_Y); const int* TOPE = (const int*)(c.ws + WS_TOPE); const int* TOPP = (const int*)(c.ws + WS_TOPP); const float* MOD = (const float*)(c.ws + WS_MOD);
    float* out = c.out;
    for (int row = B.bid * 8 + B.wave; row < NT; row += B.G * 8) {
        const int b = row / L;
        int yrow[4];
#pragma unroll
        for (int j = 0; j < 4; ++j) yrow[j] = tab[40 + TOPE[row * 4 + j]] + TOPP[row * 4 + j];
        float x2[16]; float ss = 0.f;
#pragma unroll
        for (int q = 0; q < 4; ++q) {
            const int k = (B.lane + 64 * q) * 4;
            const float4 x1 = *(const float4*)(out + (size_t)row * D + k);
            float a[4] = {0.f, 0.f, 0.f, 0.f};
#pragma unroll
            for (int j = 0; j < 4; ++j) { const ushort4 y = *(const ushort4*)(Y + (size_t)yrow[j] * D + k); a[0] += bf2f(y.x); a[1] += bf2f(y.y); a[2] += bf2f(y.z); a[3] += bf2f(y.w); }
            const float4 g2 = *(const float4*)(MOD + b * 6144 + 5120 + k);
            x2[q * 4 + 0] = x1.x + g2.x * a[0]; x2[q * 4 + 1] = x1.y + g2.y * a[1]; x2[q * 4 + 2] = x1.z + g2.z * a[2]; x2[q * 4 + 3] = x1.w + g2.w * a[3];
#pragma unroll
            for (int i = 0; i < 4; ++i) ss += x2[q * 4 + i] * x2[q * 4 + i];
        }
        ss = wave_sum(ss);
        const float rstd = rsqrtf(ss * (1.f / D) + EPS);
#pragma unroll
        for (int q = 0; q < 4; ++q) {
            const int k = (B.lane + 64 * q) * 4;
            const float4 g = *(const float4*)(c.final_g + k);
            float4 o; o.x = x2[q * 4] * rstd * g.x; o.y = x2[q * 4 + 1] * rstd * g.y; o.z = x2[q * 4 + 2] * rstd * g.z; o.w = x2[q * 4 + 3] * rstd * g.w;
            *(float4*)(out + (size_t)row * D + k) = o;
        }
    }
}

namespace pg {
#define LAS __attribute__((address_space(3)))
typedef short bf16x8 __attribute__((ext_vector_type(8)));
typedef float f32x4 __attribute__((ext_vector_type(4)));
typedef unsigned u32x4 __attribute__((ext_vector_type(4)));
typedef unsigned u32x2 __attribute__((ext_vector_type(2)));
constexpr int HTB = 128 * 64 * 2;
DI int lds_byte(int r, int c) { const int st = (r >> 4) * 2 + (c >> 5), rr = r & 15, cc = c & 31, ob = rr * 64 + cc * 2; return st * 1024 + (ob ^ (((ob >> 9) & 1) << 5)); }
DI void stage_rc(int b, int& R, int& C) { const int st = b / 1024, sb = b % 1024, swz = sb ^ (((sb >> 9) & 1) << 5); R = (st >> 1) * 16 + swz / 64; C = (st & 1) * 32 + (swz % 64) / 2; }
DI int perm32(int rho) { const int n = rho >> 4, i = rho & 15; return 8 * (i >> 2) + 4 * n + (i & 3); }
typedef float f32x2_ __attribute__((ext_vector_type(2)));
typedef __bf16 bf16x2_ __attribute__((ext_vector_type(2)));
DI unsigned cvt_pk_bf16(float lo, float hi) { const f32x2_ v = {lo, hi}; return __builtin_bit_cast(unsigned, __builtin_convertvector(v, bf16x2_)); }

struct Unit {
    const char *a0, *a1;
    const char *b0, *b1;
    unsigned v00, v01, v10, v11;
    int nt;
    int kind, pm, pn, ex;
};
DI void lane_rc(int tid, int i, int& R, int& C) { stage_rc(tid * 16 + i * 8192, R, C); }

template <bool PERM, bool GATHER, class Sched, class Epi>
DI void gemm_phase(LAS unsigned char* lds, int tid_in, int lda_elems, int ldb_elems, const Sched& S, const Epi& E) {
    const int tid = tid_in, wid = __builtin_amdgcn_readfirstlane(tid >> 6), lane = tid & 63, wr = wid >> 2, wc = wid & 3, fr = lane & 15, fq = lane >> 4;
    unsigned voffB0, voffB1, voffA0, voffA1;
    { int R, C; lane_rc(tid, 0, R, C); const int Rb = PERM ? ((R & ~31) + perm32(R & 31)) : R; voffB0 = (unsigned)(Rb * ldb_elems + C) * 2u; voffA0 = (unsigned)(R * lda_elems + C) * 2u; }
    { int R, C; lane_rc(tid, 1, R, C); const int Rb = PERM ? ((R & ~31) + perm32(R & 31)) : R; voffB1 = (unsigned)(Rb * ldb_elems + C) * 2u; voffA1 = (unsigned)(R * lda_elems + C) * 2u; }
#define VA0(u, h) (GATHER ? ((h) ? (u).v10 : (u).v00) : voffA0)
#define VA1(u, h) (GATHER ? ((h) ? (u).v11 : (u).v01) : voffA1)
    const unsigned ldsw = (unsigned)wid * 1024u;
    const int aoff = lds_byte(wr * 64 + fr, fq * 8), boff = lds_byte(wc * 32 + fr, fq * 8);
#define PG_SA(b, h) (((b) * 2 + (h)) * HTB)
#define PG_SB(b, h) ((4 + (b) * 2 + (h)) * HTB)
#define PG_STAGE2(bufoff, gbase, o0, o1) do { \
        __builtin_amdgcn_global_load_lds((const unsigned*)((const char*)(gbase) + (o0)), (LAS unsigned*)(lds + (bufoff) + ldsw), 16, 0, 0); \
        __builtin_amdgcn_global_load_lds((const unsigned*)((const char*)(gbase) + (o1)), (LAS unsigned*)(lds + (bufoff) + ldsw + 8192), 16, 0, 0); } while (0)
#define PG_STAGEB(bufoff, gbase) PG_STAGE2(bufoff, gbase, voffB0, voffB1)
#define PG_LDA(dst, b, h) do { _Pragma("unroll") for (int m = 0; m < 4; ++m) _Pragma("unroll") for (int k = 0; k < 2; ++k) dst[m][k] = *(const LAS bf16x8*)(lds + PG_SA(b, h) + aoff + m * 2048 + k * 1024); } while (0)
#define PG_LDB(dst, b, h) do { _Pragma("unroll") for (int n = 0; n < 2; ++n) _Pragma("unroll") for (int k = 0; k < 2; ++k) dst[n][k] = *(const LAS bf16x8*)(lds + PG_SB(b, h) + boff + n * 2048 + k * 1024); } while (0)
#define PG_MMA(ai, bj, At, Bt) do { __builtin_amdgcn_s_setprio(1); _Pragma("unroll") for (int m = 0; m < 4; ++m) _Pragma("unroll") for (int n = 0; n < 2; ++n) _Pragma("unroll") for (int k = 0; k < 2; ++k) \
        acc[ai][bj][m][n] = __builtin_amdgcn_mfma_f32_16x16x32_bf16(Bt[n][k], At[m][k], acc[ai][bj][m][n], 0, 0, 0); __builtin_amdgcn_s_setprio(0); } while (0)
#define PG_WAIT_V(n) asm volatile("s_waitcnt vmcnt(" #n ")" ::: "memory")
#define PG_WAIT_L(n) asm volatile("s_waitcnt lgkmcnt(" #n ")" ::: "memory")
#define PG_BAR __builtin_amdgcn_s_barrier()
#define PG_SCHED __builtin_amdgcn_sched_barrier(0)
    Unit cur, nxt; int ui = 0;
    if (!S.next(0, cur)) return;
    f32x4 acc[2][2][4][2];
#pragma unroll
    for (int a = 0; a < 2; ++a)
#pragma unroll
        for (int b = 0; b < 2; ++b)
#pragma unroll
            for (int m = 0; m < 4; ++m)
#pragma unroll
                for (int n = 0; n < 2; ++n) acc[a][b][m][n] = (f32x4){0.f, 0.f, 0.f, 0.f};
    bf16x8 At[4][2], B0[2][2], B1[2][2];
    PG_STAGEB(PG_SB(0, 0), cur.b0); PG_STAGEB(PG_SB(0, 1), cur.b1); PG_STAGE2(PG_SA(0, 0), cur.a0, VA0(cur, 0), VA1(cur, 0)); PG_STAGE2(PG_SA(0, 1), cur.a1, VA0(cur, 1), VA1(cur, 1));
    if (wr == 1) PG_BAR;
    PG_WAIT_V(2); PG_BAR;
    PG_STAGEB(PG_SB(1, 0), cur.b0 + 128); PG_STAGE2(PG_SA(1, 0), cur.a0 + 128, VA0(cur, 0), VA1(cur, 0)); PG_STAGEB(PG_SB(1, 1), cur.b1 + 128);
    PG_WAIT_V(6); PG_BAR;
    for (;;) {
        const bool has_next = S.next(ui + 1, nxt);
        if (!has_next) nxt = cur;
        const int nt = cur.nt;
        for (int t = 0; t < nt; t += 2) {
            const bool last = (t == nt - 2);
            const size_t o1 = (size_t)(t + 1) * 128, o2 = last ? 0 : (size_t)(t + 2) * 128;
            const char* a20 = (last ? nxt.a0 : cur.a0) + o2; const char* a21 = (last ? nxt.a1 : cur.a1) + o2;
            const char* b20 = (last ? nxt.b0 : cur.b0) + o2; const char* b21 = (last ? nxt.b1 : cur.b1) + o2;
            unsigned w00, w01, w10, w11;
            if (GATHER) { w00 = last ? nxt.v00 : cur.v00; w01 = last ? nxt.v01 : cur.v01; w10 = last ? nxt.v10 : cur.v10; w11 = last ? nxt.v11 : cur.v11; }
            else { w00 = voffA0; w01 = voffA1; w10 = voffA0; w11 = voffA1; }
            PG_LDB(B0, 0, 0); PG_LDB(B1, 0, 1); PG_SCHED; PG_LDA(At, 0, 0); PG_STAGE2(PG_SA(1, 1), cur.a1 + o1, VA0(cur, 1), VA1(cur, 1));
            PG_WAIT_V(8); PG_WAIT_L(0); PG_BAR; PG_MMA(0, 0, At, B0); PG_MMA(0, 1, At, B1); PG_BAR; PG_SCHED;
            PG_LDA(At, 0, 1); PG_STAGEB(PG_SB(0, 0), b20); PG_STAGEB(PG_SB(0, 1), b21); PG_STAGE2(PG_SA(0, 0), a20, w00, w01);
            PG_WAIT_V(8); PG_WAIT_L(0); PG_BAR; PG_MMA(1, 0, At, B0); PG_MMA(1, 1, At, B1); PG_BAR; PG_SCHED;
            PG_LDB(B0, 1, 0); PG_LDB(B1, 1, 1); PG_SCHED; PG_LDA(At, 1, 0); PG_STAGE2(PG_SA(0, 1), a21, w10, w11);
            PG_WAIT_V(8); PG_WAIT_L(0); PG_BAR; PG_MMA(0, 0, At, B0); PG_MMA(0, 1, At, B1); PG_BAR; PG_SCHED;
            PG_LDA(At, 1, 1); PG_STAGEB(PG_SB(1, 0), b20 + 128); PG_STAGEB(PG_SB(1, 1), b21 + 128); PG_STAGE2(PG_SA(1, 0), a20 + 128, w00, w01);
            PG_WAIT_V(8); PG_WAIT_L(0); PG_BAR; PG_MMA(1, 0, At, B0); PG_MMA(1, 1, At, B1); PG_BAR; PG_SCHED;
        }
        if (wr == 0) PG_BAR;
        E(acc, cur, wr, wc, fr, fq);
        if (!has_next) break;
#pragma unroll
        for (int a = 0; a < 2; ++a)
#pragma unroll
            for (int b = 0; b < 2; ++b)
#pragma unroll
                for (int m = 0; m < 4; ++m)
#pragma unroll
                    for (int n = 0; n < 2; ++n) acc[a][b][m][n] = (f32x4){0.f, 0.f, 0.f, 0.f};
        cur = nxt; ++ui;
        if (wr == 1) PG_BAR;
    }
    PG_WAIT_V(0);
    PG_BAR;
#undef VA0
#undef VA1
#undef PG_SA
#undef PG_SB
#undef PG_STAGE2
#undef PG_STAGEB
#undef PG_LDA
#undef PG_LDB
#undef PG_MMA
#undef PG_WAIT_V
#undef PG_WAIT_L
#undef PG_BAR
#undef PG_SCHED
}
}

constexpr size_t WS_SSP = 402 * MiB;
constexpr size_t WS_WINT = 440 * MiB;
constexpr size_t WS_WFT = WS_WINT + 11 * MiB;
constexpr size_t WS_WFOT = WS_WFT + 2 * MiB;
constexpr size_t WS_WGOT = WS_WFOT + 1 * MiB;
constexpr size_t WS_WMOT = WS_WGOT + 2 * MiB;
constexpr size_t WS_WGT = WS_B + 144 * MiB;
constexpr size_t WS_WUT = WS_WGT + 64 * MiB;
constexpr size_t WS_WDT = WS_WUT + 64 * MiB + 16 * MiB;
static_assert(WS_WMOT + 2 * MiB <= 512 * MiB && WS_WDT + 64 * MiB <= WS_WINT, "ws map");

DI unsigned pk2(float lo, float hi) { return (unsigned)f2bf(lo) | ((unsigned)f2bf(hi) << 16); }
DI void transpose_item(const float* src, int ldw, u16* WT, int K, int k0, int dst_row, float* scr, int lane, bool zero) {
    if (!zero) {
        pg::f32x4 v[8];
#pragma unroll
        for (int t = 0; t < 8; ++t) v[t] = *(const pg::f32x4*)(src + (size_t)(k0 + 8 * t + (lane >> 3)) * ldw + (lane & 7) * 4);
#pragma unroll
        for (int t = 0; t < 8; ++t) { float* d = scr + (8 * t + (lane >> 3)) * 33 + (lane & 7) * 4; d[0] = v[t][0]; d[1] = v[t][1]; d[2] = v[t][2]; d[3] = v[t][3]; }
    }
    asm volatile("s_waitcnt lgkmcnt(0)" ::: "memory");
    const int cc = lane & 7;
#pragma unroll
    for (int j = 0; j < 4; ++j) { const int n = (lane >> 3) + 8 * j; const float* s = scr + (8 * cc) * 33 + n;
        uint4 o;
        if (zero) o = make_uint4(0u, 0u, 0u, 0u);
        else { o.x = pk2(s[0 * 33], s[1 * 33]); o.y = pk2(s[2 * 33], s[3 * 33]); o.z = pk2(s[4 * 33], s[5 * 33]); o.w = pk2(s[6 * 33], s[7 * 33]); }
        *(uint4*)(WT + (size_t)(dst_row + n) * K + k0 + 8 * cc) = o; }
    asm volatile("s_waitcnt lgkmcnt(0)" ::: "memory");
}
DI void ph_wprep_small(const Ctx& c, const Blk& B, float* lds) {
    float* scr = lds + B.wave * 2176;
    u16* WINT = (u16*)(c.ws + WS_WINT); u16* WFOT = (u16*)(c.ws + WS_WFOT); u16* WGOT = (u16*)(c.ws + WS_WGOT); u16* WMOT = (u16*)(c.ws + WS_WMOT);
    constexpr int I_IN = 168 * 16, I_FO = 32 * 8, I_GO = 32 * 16, I_MO = 32 * 16;
    int* slot = (int*)(lds + 8 * 2176);
    unsigned* ctr = (unsigned*)c.ws + 2176;
    for (;;) {
        __syncthreads();
        if (B.tid == 0) *slot = (int)__hip_atomic_fetch_add(ctr, 1u, __ATOMIC_RELAXED, __HIP_MEMORY_SCOPE_AGENT);
        __syncthreads();
        const int it = *slot * 8 + B.wave;
        if (*slot * 8 >= I_IN + I_FO + I_GO + I_MO) break;
        if (it >= I_IN + I_FO + I_GO + I_MO) continue;
        int r = it;
        if (r < I_IN) { const int nb = r >> 4, kb = r & 15, n0 = nb * 32;
            int sc; bool zero = false;
            if (n0 < 2048) sc = n0; else if (n0 < 3072) sc = 2080 + (n0 - 2048); else if (n0 < 4096) sc = 3616 + (n0 - 3072); else if (n0 < 5120) sc = 4640 + (n0 - 4096); else if (n0 < 5152) sc = 2048; else { sc = 0; zero = true; }
            transpose_item(c.w_in + sc, IN_COLS, WINT, 1024, kb * 64, n0, scr, B.lane, zero); continue; }
        r -= I_IN;
        if (r < I_FO) { const int nb = r >> 3, kb = r & 7; transpose_item(c.w_fo + nb * 32, 1024, WFOT, 512, kb * 64, nb * 32, scr, B.lane, false); continue; }
        r -= I_FO;
        if (r < I_GO) { const int nb = r >> 4, kb = r & 15; transpose_item(c.w_go + nb * 32, 1024, WGOT, 1024, kb * 64, nb * 32, scr, B.lane, false); continue; }
        r -= I_GO;
        { const int nb = r >> 4, kb = r & 15; transpose_item(c.w_mo + nb * 32, 1024, WMOT, 1024, kb * 64, nb * 32, scr, B.lane, false); }
    }
}
DI size_t early_off(int m) { return m < 14 ? ((size_t)424 * MiB + (size_t)m * 2 * MiB) : m < 38 ? ((size_t)458 * MiB + (size_t)(m - 14) * 2 * MiB) : ((size_t)507 * MiB + (size_t)(m - 38) * 2 * MiB); }
DI size_t gate_off(int e) { return early_off(e); }
DI size_t up_off(int e) { return e < 8 ? early_off(32 + e) : (WS_WUT + (size_t)e * 2 * MiB); }
constexpr int N_EARLY = 40;
DI void transpose64(const float* W, u16* WT, float* scr, int lane) {
    pg::f32x4 v[16];
#pragma unroll
    for (int t = 0; t < 16; ++t) v[t] = *(const pg::f32x4*)(W + (size_t)(4 * t + (lane >> 4)) * D + (lane & 15) * 4);
#pragma unroll
    for (int t = 0; t < 16; ++t) { float* d = scr + (4 * t + (lane >> 4)) * 65 + (lane & 15) * 4; d[0] = v[t][0]; d[1] = v[t][1]; d[2] = v[t][2]; d[3] = v[t][3]; }
    asm volatile("s_waitcnt lgkmcnt(0)" ::: "memory");
    const int cc = lane & 7;
#pragma unroll
    for (int j = 0; j < 8; ++j) { const int n = (lane >> 3) + 8 * j; const float* s = scr + (8 * cc) * 65 + n;
        uint4 o; o.x = pk2(s[0 * 65], s[1 * 65]); o.y = pk2(s[2 * 65], s[3 * 65]); o.z = pk2(s[4 * 65], s[5 * 65]); o.w = pk2(s[6 * 65], s[7 * 65]);
        *(uint4*)(WT + (size_t)n * D + 8 * cc) = o; }
    asm volatile("s_waitcnt lgkmcnt(0)" ::: "memory");
}
DI void wprep_gate_queue(const Ctx& c, const Blk& B, unsigned char* lds_raw) {
    float* scr = (float*)lds_raw + B.wave * 4160;
    LAS int* slot = (LAS int*)((LAS unsigned char*)lds_raw + 140000);
    unsigned* ctr = (unsigned*)c.ws + 2240;
    for (;;) {
        __syncthreads();
        if (B.tid == 0) *slot = (int)__hip_atomic_fetch_add(ctr, 1u, __ATOMIC_RELAXED, __HIP_MEMORY_SCOPE_AGENT);
        __syncthreads();
        const int bi = *slot;
        if (bi >= N_EARLY * 32) break;
        const int it = bi * 8 + B.wave, m = it >> 8, r = it & 255, nb = r >> 4, kb = r & 15;
        transpose64((m < 32 ? c.w_gate + (size_t)m * D * D : c.w_up + (size_t)(m - 32) * D * D) + (size_t)(kb * 64) * D + nb * 64, (u16*)(c.ws + early_off(m)) + (size_t)(nb * 64) * D + kb * 64, scr, B.lane);
    }
}
DI void ph_wprep_moe(const Ctx& c, const Blk& B, float* lds) {
    float* scr = lds + B.wave * 4160;
    const int lane = B.lane, nit = 3, it0 = B.bid * 24 + B.wave * 3;
    for (int j0 = 0; j0 < nit; ++j0) {
        const int it = it0 + j0;
        const int e = 8 + (it >> 8), r = it & 255, nb = r >> 4, kb = r & 15;
        transpose64(c.w_up + (size_t)e * D * D + (size_t)(kb * 64) * D + nb * 64, (u16*)(c.ws + up_off(e)) + (size_t)(nb * 64) * D + kb * 64, scr, lane);
    }
}
DI float cos_rev(int ix, float inv) { return __builtin_amdgcn_cosf((float)ix * inv); }
DI void ph_wprep_fourier(const Ctx& c, const Blk& B, float* lds) {
    u16* WFT = (u16*)(c.ws + WS_WFT);
    float* tile = lds;
    const int lane = B.lane, i16 = lane & 15, kq = lane >> 4, nt = B.wave & 3, mp = B.wave >> 2;
    for (int item = B.bid; item < 256; item += B.G) {
        const int g = item >> 6, k0 = ((item >> 2) & 15) * 64, mpart = item & 3;
        __syncthreads();
#pragma unroll
        for (int t = 0; t < 4; ++t) { const int ix = B.tid + 512 * t, r = ix >> 5, c4 = (ix & 31) * 4;
            const float* sp = c.w_in + (size_t)(k0 + r) * IN_COLS + 3104 + g * 128 + c4;
            *(pg::f32x4*)(tile + r * 132 + c4) = *(const pg::f32x4*)sp; }
        __syncthreads();
        const int m = mpart * 32 + (nt & 1) * 16 + i16, ph = (nt >> 1) ? 96 : 0;
        pg::f32x4 a0 = (pg::f32x4){0.f, 0.f, 0.f, 0.f}, a1 = a0;
        const float* ta = tile + (mp * 32 + i16) * 132 + kq;
#pragma unroll 8
        for (int s = 0; s < 32; ++s) {
            const float bv = cos_rev(((4 * s + kq) * m + ph) & 127, 1.f / 128.f);
            a0 = __builtin_amdgcn_mfma_f32_16x16x4f32(ta[4 * s], bv, a0, 0, 0, 0);
            a1 = __builtin_amdgcn_mfma_f32_16x16x4f32(ta[16 * 132 + 4 * s], bv, a1, 0, 0, 0);
        }
        u16* orow = WFT + (size_t)((nt >> 1) * 512 + g * 128 + m) * 1024 + k0 + mp * 32 + 4 * kq;
        *(uint2*)orow = make_uint2(pg::cvt_pk_bf16(a0[0], a0[1]), pg::cvt_pk_bf16(a0[2], a0[3])); *(uint2*)(orow + 16) = make_uint2(pg::cvt_pk_bf16(a1[0], a1[1]), pg::cvt_pk_bf16(a1[2], a1[3]));
    }
    __syncthreads();
}

struct SchedG1 {
    const char* U; const char* WINT; const char* WFT; const char* UEO; int G, c;
    DI bool next(int i, pg::Unit& u) const {
        const int Lx = i * G + c;
        if (Lx >= 1508) return false;
        const char *a, *b;
        if (Lx < 1344) {
            int wgid = Lx; { const int nwg = 1344, q = nwg / 8, r = nwg % 8, xcd = wgid % 8, off = wgid / 8; wgid = (xcd < r ? xcd * (q + 1) : r * (q + 1) + (xcd - r) * q) + off; }
            const int nig = 8 * 21, gid = wgid / nig, fm = gid * 8, gsz = (64 - fm) < 8 ? (64 - fm) : 8;
            u.pm = fm + ((wgid % nig) % gsz); u.pn = (wgid % nig) / gsz; u.kind = 0;
            a = U + (size_t)u.pm * 256 * 2048; b = WINT + (size_t)u.pn * 256 * 2048;
        } else if (Lx < 1380) {
            const int r = Lx - 1344, j = r % 9; u.pm = 64 + r / 9; u.pn = j < 8 ? j : 20; u.kind = 0;
            a = U + (size_t)u.pm * 256 * 2048; b = WINT + (size_t)u.pn * 256 * 2048;
        } else {
            const int r = Lx - 1380; u.pm = r >> 5; u.pn = r & 31; u.kind = 1;
            a = WFT + (size_t)u.pm * 256 * 2048; b = UEO + (size_t)(u.pm >> 1) * 8192 * 2048 + (size_t)u.pn * 256 * 2048;
        }
        u.a0 = a; u.a1 = a + 128 * 2048; u.b0 = b; u.b1 = b + 128 * 2048; u.v00 = u.v01 = u.v10 = u.v11 = 0u;
        u.nt = 16; u.ex = 0;
        return true;
    }
};
DI float fsilu(float v) { return v / (1.f + __expf(-v)); }
DI float fsigm(float v) { return 1.f / (1.f + __expf(-v)); }
struct EpiG1 {
    u16 *QKV, *SZ, *GA, *GB, *FT2; float* BA;
    DI void operator()(const pg::f32x4 (&acc)[2][2][4][2], const pg::Unit& u, int wr, int wc, int fr, int fq) const {
        const int c0 = wc * 32 + 8 * fq;
        if (u.kind == 0 && u.pn == 20) {
            if (wc == 0) {
#pragma unroll
                for (int ai = 0; ai < 2; ++ai)
#pragma unroll
                    for (int m = 0; m < 4; ++m) { const size_t row = (size_t)u.pm * 256 + ai * 128 + wr * 64 + m * 16 + fr;
                        *(pg::f32x4*)(BA + row * 32 + c0) = acc[ai][0][m][0]; *(pg::f32x4*)(BA + row * 32 + c0 + 4) = acc[ai][0][m][1]; }
            }
            return;
        }
        u16* base; size_t pitch; int mode;
        size_t rowbase;
        if (u.kind == 0) {
            rowbase = (size_t)u.pm * 256;
            if (u.pn < 8) { base = QKV + u.pn * 256; pitch = 2048; mode = 0; }
            else if (u.pn < 12) { base = SZ + (u.pn - 8) * 256; pitch = 1024; mode = 1; }
            else if (u.pn < 16) { base = GA + (u.pn - 12) * 256; pitch = 1024; mode = 2; }
            else { base = GB + (u.pn - 16) * 256; pitch = 1024; mode = 2; }
        } else {
            const int cs = u.pm >> 1, bb = u.pn >> 3;
            base = FT2 + ((size_t)bb * 512 + (u.pm & 1) * 256) * 4096 + cs * 2048 + (u.pn & 7) * 256; pitch = 4096; mode = 0; rowbase = 0;
        }
#pragma unroll
        for (int ai = 0; ai < 2; ++ai)
#pragma unroll
            for (int m = 0; m < 4; ++m) { u16* rowp = base + (rowbase + ai * 128 + wr * 64 + m * 16 + fr) * pitch + c0;
#pragma unroll
                for (int bj = 0; bj < 2; ++bj) { pg::f32x4 v0 = acc[ai][bj][m][0], v1 = acc[ai][bj][m][1];
                    if (mode == 1) {
#pragma unroll
                        for (int j = 0; j < 4; ++j) { v0[j] = fsilu(v0[j]); v1[j] = fsilu(v1[j]); } }
                    else if (mode == 2) {
#pragma unroll
                        for (int j = 0; j < 4; ++j) { v0[j] = fsigm(v0[j]); v1[j] = fsigm(v1[j]); } }
                    pg::u32x4 w; w.x = pg::cvt_pk_bf16(v0[0], v0[1]); w.y = pg::cvt_pk_bf16(v0[2], v0[3]); w.z = pg::cvt_pk_bf16(v1[0], v1[1]); w.w = pg::cvt_pk_bf16(v1[2], v1[3]);
                    *(pg::u32x4*)(rowp + bj * 128) = w; } }
    }
};
DI void ph_gemm1(const Ctx& c, const Blk& B, unsigned char* lds_raw) {
    SchedG1 S; S.U = c.ws + WS_U; S.WINT = c.ws + WS_WINT; S.WFT = c.ws + WS_WFT; S.UEO = c.ws + WS_FT2N; S.G = B.G; S.c = B.bid;
    EpiG1 E{(u16*)(c.ws + WS_QKV), (u16*)(c.ws + WS_SZ), (u16*)(c.ws + WS_GA), (u16*)(c.ws + WS_GB), (u16*)((char*)c.out + FE_OUT_OFF), (float*)(c.ws + WS_BA)};
    pg::gemm_phase<true, false>((LAS unsigned char*)lds_raw, B.tid, 1024, 1024, S, E);
}

struct SchedTile {
    const char* A; const char* Bt; int lda, G, c;
    DI bool next(int i, pg::Unit& u) const {
        const int Lx = i * G + c; if (Lx >= 256) return false;
        int wgid = Lx; { const int xcd = wgid % 8, off = wgid / 8; wgid = xcd * 32 + off; }
        u.pm = (wgid >> 5) * 8 + (wgid & 7); u.pn = (wgid >> 3) & 3; u.kind = 0; u.ex = 0; u.nt = lda / 64;
        const char* a = A + (size_t)u.pm * 256 * lda * 2; const char* b = Bt + (size_t)u.pn * 256 * lda * 2;
        u.a0 = a; u.a1 = a + (size_t)128 * lda * 2; u.b0 = b; u.b1 = b + (size_t)128 * lda * 2; u.v00 = u.v01 = u.v10 = u.v11 = 0u;
        return true;
    }
};
DI pg::f32x4 bf4lo(pg::u32x4 w, int half) {
    const unsigned a = half ? w.z : w.x, b = half ? w.w : w.y;
    return (pg::f32x4){__uint_as_float(a << 16), __uint_as_float(a & 0xffff0000u), __uint_as_float(b << 16), __uint_as_float(b & 0xffff0000u)};
}
template <int MODE>
struct EpiMerge {
    u16* OUT; const u16* G; const u16* T1;
    DI void operator()(const pg::f32x4 (&acc)[2][2][4][2], const pg::Unit& u, int wr, int wc, int fr, int fq) const {
        const int c0 = u.pn * 256 + wc * 32 + 8 * fq;
#pragma unroll
        for (int ai = 0; ai < 2; ++ai)
#pragma unroll
            for (int m = 0; m < 4; ++m) { const size_t off = (size_t)(u.pm * 256 + ai * 128 + wr * 64 + m * 16 + fr) * 1024 + c0;
#pragma unroll
                for (int bj = 0; bj < 2; ++bj) {
                    const pg::u32x4 gw = *(const pg::u32x4*)(G + off + bj * 128);
                    pg::f32x4 v0 = acc[ai][bj][m][0] * bf4lo(gw, 0), v1 = acc[ai][bj][m][1] * bf4lo(gw, 1);
                    if (MODE == 1) { const pg::u32x4 tw = *(const pg::u32x4*)(T1 + off + bj * 128); v0 += bf4lo(tw, 0); v1 += bf4lo(tw, 1); }
                    pg::u32x4 w; w.x = pg::cvt_pk_bf16(v0[0], v0[1]); w.y = pg::cvt_pk_bf16(v0[2], v0[3]); w.z = pg::cvt_pk_bf16(v1[0], v1[1]); w.w = pg::cvt_pk_bf16(v1[2], v1[3]);
                    *(pg::u32x4*)(OUT + off + bj * 128) = w; } }
    }
};
struct EpiX1f {
    float* X1; const float* x; const float* MOD; float* SSP;
    DI void operator()(const pg::f32x4 (&acc)[2][2][4][2], const pg::Unit& u, int wr, int wc, int fr, int fq) const {
        const int c0 = u.pn * 256 + wc * 32 + 4 * fq;
        const float* g1 = MOD + (u.pm >> 4) * 6144 + 2048;
#pragma unroll
        for (int ai = 0; ai < 2; ++ai)
#pragma unroll
            for (int m = 0; m < 4; ++m) { const int row = u.pm * 256 + ai * 128 + wr * 64 + m * 16 + fr; const size_t off = (size_t)row * 1024 + c0;
                float ss = 0.f;
#pragma unroll
                for (int bj = 0; bj < 2; ++bj)
#pragma unroll
                    for (int n = 0; n < 2; ++n) { const int cc = bj * 128 + n * 16;
                        const pg::f32x4 xv = *(const pg::f32x4*)(x + off + cc), gv = *(const pg::f32x4*)(g1 + c0 + cc);
                        const pg::f32x4 o = xv + gv * acc[ai][bj][m][n];
                        ss += o[0] * o[0] + o[1] * o[1] + o[2] * o[2] + o[3] * o[3];
                        *(pg::f32x4*)(X1 + off + cc) = o; }
                ss += __shfl_xor(ss, 16); ss += __shfl_xor(ss, 32);
                if (fq == 0) SSP[(size_t)(u.pn * 4 + wc) * NT + row] = ss; }
    }
};
DI void ph_merge_ab(const Ctx& c, const Blk& B, unsigned char* lds_raw) {
    { SchedTile S{c.ws + WS_FM2, c.ws + WS_WFOT, 512, B.G, B.bid}; EpiMerge<0> E{(u16*)(c.ws + WS_T1), (const u16*)(c.ws + WS_GA), nullptr};
      pg::gemm_phase<true, false>((LAS unsigned char*)lds_raw, B.tid, 512, 512, S, E); }
    { SchedTile S{c.ws + WS_OB, c.ws + WS_WGOT, 1024, B.G, B.bid}; EpiMerge<1> E{(u16*)(c.ws + WS_M1), (const u16*)(c.ws + WS_GB), (const u16*)(c.ws + WS_T1)};
      pg::gemm_phase<true, false>((LAS unsigned char*)lds_raw, B.tid, 1024, 1024, S, E); }
}
DI void ph_merge_c(const Ctx& c, const Blk& B, unsigned char* lds_raw) {
    SchedTile S{c.ws + WS_M1, c.ws + WS_WMOT, 1024, B.G, B.bid}; EpiX1f E{c.out, c.x, (const float*)(c.ws + WS_MOD), (float*)(c.ws + WS_SSP)};
    pg::gemm_phase<false, false>((LAS unsigned char*)lds_raw, B.tid, 1024, 1024, S, E);
}

constexpr int MOE_TAB = 131072 + 1024;
DI void moe_tables256(const Ctx& c, const Blk& B, LAS int* T) {
    const int* cnt = (const int*)(c.ws + WS_CTL);
    __syncthreads();
    if (B.tid == 0) { int ts = 0; for (int e = 0; e < 32; ++e) { const int n = cnt[64 * e]; T[e] = ts; T[40 + e] = n; ts += (n + 255) >> 8; } T[32] = ts; }
    __syncthreads();
}
template <bool DOWN>
struct SchedMoE {
    const LAS int* T; const char* A; const char* W0; const char* W1; const int* TOKE; int G, c, tid;
    DI bool next(int i, pg::Unit& u) const {
        constexpr int NPN = DOWN ? 4 : 8;
        const int total = T[32] * NPN;
        const int Lx = i * G + (c & 7) * (G >> 3) + (c >> 3);
        if (Lx >= total) return false;
        const int tl = Lx / NPN, pn = Lx % NPN;
        int e = 0;
        for (int k = 1; k < 32; ++k) if (tl >= T[k]) e = k;
        const int mt = tl - T[e];
        u.pm = tl; u.pn = pn; u.kind = e; u.ex = mt; u.nt = 16;
        if (DOWN) {
            const char* a = A + (size_t)tl * 256 * 2048; const char* b = W0 + ((size_t)e * 1024 + pn * 256) * 2048;
            u.a0 = a; u.a1 = a + 128 * 2048; u.b0 = b; u.b1 = b + 128 * 2048; u.v00 = u.v01 = u.v10 = u.v11 = 0u;
        } else {
            const size_t wo = ((size_t)e * 1024 + pn * 128) * 2048;
            u.a0 = A; u.a1 = A; u.b0 = W0 + gate_off(e) + (size_t)pn * 128 * 2048; u.b1 = W0 + up_off(e) + (size_t)pn * 128 * 2048; (void)wo;
            const int n = T[40 + e], r0 = mt * 256; const int* tk = TOKE + e * CAP;
            int R0, C0, R1, C1; pg::lane_rc(tid, 0, R0, C0); pg::lane_rc(tid, 1, R1, C1);
            const int i00 = min(r0 + R0, n - 1), i01 = min(r0 + R1, n - 1), i10 = min(r0 + 128 + R0, n - 1), i11 = min(r0 + 128 + R1, n - 1);
            u.v00 = (unsigned)(tk[i00] * 1024 + C0) * 2u; u.v01 = (unsigned)(tk[i01] * 1024 + C1) * 2u;
            u.v10 = (unsigned)(tk[i10] * 1024 + C0) * 2u; u.v11 = (unsigned)(tk[i11] * 1024 + C1) * 2u;
        }
        return true;
    }
};
struct EpiGU {
    u16* ACT; const float* bg; const float* bu;
    DI void operator()(const pg::f32x4 (&acc)[2][2][4][2], const pg::Unit& u, int wr, int wc, int fr, int fq) const {
        const int col = u.pn * 128 + wc * 32 + 8 * fq;
        const float* pg_ = bg + u.kind * 1024 + col; const float* pu_ = bu + u.kind * 1024 + col;
        const pg::f32x4 bg0 = *(const pg::f32x4*)pg_, bg1 = *(const pg::f32x4*)(pg_ + 4), bu0 = *(const pg::f32x4*)pu_, bu1 = *(const pg::f32x4*)(pu_ + 4);
#pragma unroll
        for (int ai = 0; ai < 2; ++ai)
#pragma unroll
            for (int m = 0; m < 4; ++m) {
                float o[8];
#pragma unroll
                for (int n = 0; n < 2; ++n)
#pragma unroll
                    for (int j = 0; j < 4; ++j) {
                        const float gt = fminf(acc[ai][0][m][n][j] + (n ? bg1[j] : bg0[j]), 7.f);
                        const float up = fminf(fmaxf(acc[ai][1][m][n][j] + (n ? bu1[j] : bu0[j]), -7.f), 7.f);
                        o[n * 4 + j] = (up + 1.f) * gt / (1.f + __expf(-1.702f * gt));
                    }
                pg::u32x4 w; w.x = pg::cvt_pk_bf16(o[0], o[1]); w.y = pg::cvt_pk_bf16(o[2], o[3]); w.z = pg::cvt_pk_bf16(o[4], o[5]); w.w = pg::cvt_pk_bf16(o[6], o[7]);
                *(pg::u32x4*)(ACT + (size_t)(u.pm * 256 + ai * 128 + wr * 64 + m * 16 + fr) * 1024 + col) = w;
            }
    }
};
struct EpiDown {
    u16* Y; const float* bd; const float* WTE;
    DI void operator()(const pg::f32x4 (&acc)[2][2][4][2], const pg::Unit& u, int wr, int wc, int fr, int fq) const {
        const int c0 = u.pn * 256 + wc * 32 + 8 * fq;
        const float* pb = bd + u.kind * 1024 + c0;
        pg::f32x4 b0[2], b1[2];
#pragma unroll
        for (int bj = 0; bj < 2; ++bj) { b0[bj] = *(const pg::f32x4*)(pb + bj * 128); b1[bj] = *(const pg::f32x4*)(pb + bj * 128 + 4); }
#pragma unroll
        for (int ai = 0; ai < 2; ++ai)
#pragma unroll
            for (int m = 0; m < 4; ++m) { const int rt = ai * 128 + wr * 64 + m * 16 + fr;
                const float wt = WTE[u.kind * CAP + u.ex * 256 + rt];
                u16* rowp = Y + (size_t)(u.pm * 256 + rt) * 1024 + c0;
#pragma unroll
                for (int bj = 0; bj < 2; ++bj) { const pg::f32x4 v0 = (acc[ai][bj][m][0] + b0[bj]) * wt, v1 = (acc[ai][bj][m][1] + b1[bj]) * wt;
                    pg::u32x4 w; w.x = pg::cvt_pk_bf16(v0[0], v0[1]); w.y = pg::cvt_pk_bf16(v0[2], v0[3]); w.z = pg::cvt_pk_bf16(v1[0], v1[1]); w.w = pg::cvt_pk_bf16(v1[2], v1[3]);
                    *(pg::u32x4*)(rowp + bj * 128) = w; } }
    }
};
DI void wprep_down_queue(const Ctx& c, const Blk& B, unsigned char* lds_raw) {
    float* scr = (float*)lds_raw + B.wave * 4160;
    LAS int* slot = (LAS int*)((LAS unsigned char*)lds_raw + 140000);
    unsigned* ctr = (unsigned*)c.ws + 2112;
    const int lane = B.lane;
    for (;;) {
        __syncthreads();
        if (B.tid == 0) *slot = (int)__hip_atomic_fetch_add(ctr, 1u, __ATOMIC_RELAXED, __HIP_MEMORY_SCOPE_AGENT);
        __syncthreads();
        const int bi = *slot;
        if (bi >= 1024) break;
        const int it = bi * 8 + B.wave, e = it >> 8, r = it & 255, nb = r >> 4, kb = r & 15;
        transpose64(c.w_down + (size_t)e * D * D + (size_t)(kb * 64) * D + nb * 64, (u16*)(c.ws + WS_WDT) + (size_t)e * D * D + (size_t)(nb * 64) * D + kb * 64, scr, lane);
    }
}
DI void ph_moe_gu(const Ctx& c, const Blk& B, unsigned char* lds_raw) {
    LAS int* T = (LAS int*)((LAS unsigned char*)lds_raw + MOE_TAB);
    moe_tables256(c, B, T);
    SchedMoE<false> S{T, c.ws + WS_H2, c.ws, c.ws + WS_WUT, (const int*)(c.ws + WS_TOKE), B.G, B.bid, B.tid};
    EpiGU E{(u16*)(c.ws + WS_ACT), c.b_gate, c.b_up};
    pg::gemm_phase<true, true>((LAS unsigned char*)lds_raw, B.tid, 1024, 1024, S, E);
}
DI void ph_moe_down(const Ctx& c, const Blk& B, unsigned char* lds_raw) {
    LAS int* T = (LAS int*)((LAS unsigned char*)lds_raw + MOE_TAB);
    moe_tables256(c, B, T);
    SchedMoE<true> S{T, c.ws + WS_ACT, c.ws + WS_WDT, nullptr, nullptr, B.G, B.bid, B.tid};
    EpiDown E{(u16*)(c.ws + WS_Y), c.b_down, (const float*)(c.ws + WS_WTE)};
    pg::gemm_phase<true, false>((LAS unsigned char*)lds_raw, B.tid, 1024, 1024, S, E);
}


typedef short bf16x8 __attribute__((ext_vector_type(8)));
typedef short bf16x4 __attribute__((ext_vector_type(4)));
typedef float f32x4 __attribute__((ext_vector_type(4)));
DI f32x4 mfma16(bf16x8 a, bf16x8 b, f32x4 c) { return __builtin_amdgcn_mfma_f32_16x16x32_bf16(a, b, c, 0, 0, 0); }
DI bf16x8 frag_nat(const LAS unsigned char* p) { return *(const LAS bf16x8*)p; }
DI bf16x8 frag_perm(const LAS unsigned char* p) {
    const bf16x4 lo = *(const LAS bf16x4*)p, hi = *(const LAS bf16x4*)(p + 32);
    return __builtin_shufflevector(lo, hi, 0, 1, 2, 3, 4, 5, 6, 7);
}
DI bf16x8 pack8(f32x4 a, f32x4 b) {
    typedef unsigned u32x4_ __attribute__((ext_vector_type(4)));
    u32x4_ w; w.x = pg::cvt_pk_bf16(a[0], a[1]); w.y = pg::cvt_pk_bf16(a[2], a[3]); w.z = pg::cvt_pk_bf16(b[0], b[1]); w.w = pg::cvt_pk_bf16(b[2], b[3]);
    return __builtin_bit_cast(bf16x8, w);
}
DI unsigned long long pack4(f32x4 a) { return (unsigned long long)pg::cvt_pk_bf16(a[0], a[1]) | ((unsigned long long)pg::cvt_pk_bf16(a[2], a[3]) << 32); }

constexpr int PL_Q = 0, PL_K = 17408, PL_KT = 36864, PL_VT = 55296, PL_KK = 92160, PL_G = 108544, PL_T01 = 110592, PL_T23 = 0;

#define DEF_N0(b_) ((b_) < 2 ? 31 : 37)
#define DEF_FLAG(d_) (4096 + 16 * (d_))
DI void ph_gdn_prep(const Ctx& c, const Blk& B, unsigned char* lds_raw, const int mode) {
    LAS unsigned char* lds = (LAS unsigned char*)lds_raw;
    const u16* QKV = (const u16*)(c.ws + WS_QKV); const float* BA = (const float*)(c.ws + WS_BA);
    const int tid = B.tid, lane = B.lane, wave = B.wave;
    for (int m = mode ? B.bid - 128 : B.bid; m < (mode ? 64 : 1024); m += (mode ? B.G - 128 : B.G)) {
        int b, n, hq;
        if (mode) { b = m >> 4; n = DEF_N0(b) + ((m >> 2) & 3); hq = m & 3; }
        else { b = m >> 8; const int j = (m >> 2) & 63; hq = m & 3; n = j < DEF_N0(b) ? j : j + 4; }
        const bool isctx = n < 4;
        unsigned char* imgh = (unsigned char*)c.ws + WS_IMGH + (size_t)((b * 68 + n) * 4 + hq) * IMGH_STRIDE;
        {
            const int cg = tid & 127, run = tid >> 7, c0 = run * 16;
            const int gcol = cg < 32 ? (hq * 128 + cg * 4) : cg < 64 ? (512 + hq * 128 + (cg - 32) * 4) : (1024 + hq * 256 + (cg - 64) * 4);
            float w[9][4];
#pragma unroll
            for (int t = 0; t < 9; ++t) { const float4 wv = *(const float4*)(c.conv_w + t * 2048 + gcol); w[t][0] = wv.x; w[t][1] = wv.y; w[t][2] = wv.z; w[t][3] = wv.w; }
            int rb[3];
#pragma unroll
            for (int dr = 0; dr < 3; ++dr) {
                if (isctx) rb[dr] = (dr == 1) ? (NT + b * CT + n * 64) : -1;
                else { const int gr = (n - 4) + dr - 1; rb[dr] = (gr >= 0 && gr < 64) ? (b * L + gr * 64) : -1; }
            }
            const int cmin = isctx ? (n == 0 ? 0 : -1) : 0, cmax = isctx ? (n == 3 ? 63 : 64) : 63;
            float win[3][3][4];
#define LOADCOL(dst_dc, colv) do { _Pragma("unroll") for (int dr = 0; dr < 3; ++dr) { \
                const bool ok = rb[dr] >= 0 && (colv) >= cmin && (colv) <= cmax; \
                ushort4 x4 = make_ushort4(0, 0, 0, 0); if (ok) x4 = *(const ushort4*)(QKV + (size_t)(rb[dr] + (colv)) * 2048 + gcol); \
                win[dr][dst_dc][0] = bf2f(x4.x); win[dr][dst_dc][1] = bf2f(x4.y); win[dr][dst_dc][2] = bf2f(x4.z); win[dr][dst_dc][3] = bf2f(x4.w); } } while (0)
            LOADCOL(0, c0 - 1); LOADCOL(1, c0);
#pragma unroll
            for (int hf = 0; hf < 2; ++hf) {
                float outv[8][4];
#pragma unroll
                for (int i = 0; i < 8; ++i) {
                    LOADCOL(2, c0 + hf * 8 + i + 1);
#pragma unroll
                    for (int ch = 0; ch < 4; ++ch) {
                        float a = 0.f;
#pragma unroll
                        for (int dr = 0; dr < 3; ++dr)
#pragma unroll
                            for (int dc = 0; dc < 3; ++dc) a += win[dr][dc][ch] * w[dr * 3 + dc][ch];
                        outv[i][ch] = a / (1.f + __expf(-a));
                    }
#pragma unroll
                    for (int dr = 0; dr < 3; ++dr)
#pragma unroll
                        for (int ch = 0; ch < 4; ++ch) { win[dr][0][ch] = win[dr][1][ch]; win[dr][1][ch] = win[dr][2][ch]; }
                }
                const int cb0 = c0 + hf * 8;
                if ((wave & 1) == 0) {
#pragma unroll
                    for (int i = 0; i < 8; ++i) {
                        float ss = outv[i][0] * outv[i][0] + outv[i][1] * outv[i][1] + outv[i][2] * outv[i][2] + outv[i][3] * outv[i][3];
                        ss += __shfl_xor(ss, 1); ss += __shfl_xor(ss, 2); ss += __shfl_xor(ss, 4); ss += __shfl_xor(ss, 8); ss += __shfl_xor(ss, 16);
                        const float sc = rsqrtf(ss + EPS) * (lane < 32 ? 0.08838834764831845f : 1.f);
#pragma unroll
                        for (int ch = 0; ch < 4; ++ch) outv[i][ch] *= sc;
                    }
                    const int d0 = (lane & 31) * 4;
                    LAS unsigned char* nat = lds + (lane < 32 ? PL_Q : PL_K);
#pragma unroll
                    for (int i = 0; i < 8; ++i) *(LAS unsigned long long*)(nat + (cb0 + i) * 272 + d0 * 2) = pack4((f32x4){outv[i][0], outv[i][1], outv[i][2], outv[i][3]});
                    if (lane >= 32) {
#pragma unroll
                        for (int ch = 0; ch < 4; ++ch)
                            *(LAS bf16x8*)(lds + PL_KT + (d0 + ch) * 144 + cb0 * 2) = pack8((f32x4){outv[0][ch], outv[1][ch], outv[2][ch], outv[3][ch]}, (f32x4){outv[4][ch], outv[5][ch], outv[6][ch], outv[7][ch]});
                    }
                } else {
                    const int dv0 = (cg - 64) * 4;
#pragma unroll
                    for (int ch = 0; ch < 4; ++ch)
                        *(LAS bf16x8*)(lds + PL_VT + (dv0 + ch) * 144 + cb0 * 2) = pack8((f32x4){outv[0][ch], outv[1][ch], outv[2][ch], outv[3][ch]}, (f32x4){outv[4][ch], outv[5][ch], outv[6][ch], outv[7][ch]});
                }
                asm volatile("" ::: "memory");
            }
#undef LOADCOL
        }
        if (wave < 4) {
            const int hvl = wave >> 1, dir = wave & 1, hv = hq * 2 + hvl;
            const int row = isctx ? (NT + b * CT + n * 64 + lane) : (b * L + (n - 4) * 64 + lane);
            const float beta = 1.f / (1.f + expf(-BA[(size_t)row * 32 + dir * 8 + hv]));
            const float lg = -expf(c.a_log[dir * 8 + hv]) * softplusf_(BA[(size_t)row * 32 + 16 + dir * 8 + hv] + c.dt_bias[dir * 8 + hv]);
            float gc = lg;
            if (dir == 0) {
#pragma unroll
                for (int o = 1; o < 64; o <<= 1) { const float t = __shfl_up(gc, o); if (lane >= o) gc += t; }
            } else {
#pragma unroll
                for (int o = 1; o < 64; o <<= 1) { const float t = __shfl_down(gc, o); if (lane + o < 64) gc += t; }
            }
            const float ge = __shfl(gc, dir ? 0 : 63);
            LAS float* gl = (LAS float*)(lds + PL_G + wave * 512);
            gl[lane] = beta; gl[64 + lane] = gc;
            float* gi = (float*)((unsigned char*)c.ws + WS_IMGHD + (size_t)(((b * 68 + n) * 8 + hv) * 2 + dir) * IMGHD_STRIDE + ID_G);
            gi[lane] = expf(gc); gi[64 + lane] = expf(ge - gc); if (lane == 0) gi[128] = expf(ge);
        }
        __syncthreads();
        for (int ch = tid; ch < 1088 + 1152; ch += 512) {
            if (ch < 1088) *(pg::u32x4*)(imgh + IH_Q + ch * 16) = *(const LAS pg::u32x4*)(lds + PL_Q + ch * 16);
            else *(pg::u32x4*)(imgh + IH_KT + (ch - 1088) * 16) = *(const LAS pg::u32x4*)(lds + PL_KT + (ch - 1088) * 16);
        }
        {
            const int it = wave & 3, fr = lane & 15, qd = lane >> 4;
            const LAS unsigned char* xs = lds + (wave < 4 ? PL_K : PL_Q);
            bf16x8 xf[4];
#pragma unroll
            for (int ks = 0; ks < 4; ++ks) xf[ks] = frag_nat(xs + (it * 16 + fr) * 272 + ks * 64 + qd * 16);
            const int i = it * 16 + fr;
#pragma unroll
            for (int g = 0; g < 2; ++g) {
                f32x4 acc[2];
#pragma unroll
                for (int sub = 0; sub < 2; ++sub) {
                    acc[sub] = (f32x4){0.f, 0.f, 0.f, 0.f};
                    const int prow = 32 * g + 8 * (fr >> 2) + 4 * sub + (fr & 3);
#pragma unroll
                    for (int ks = 0; ks < 4; ++ks) acc[sub] = mfma16(frag_nat(lds + PL_K + prow * 272 + ks * 64 + qd * 16), xf[ks], acc[sub]);
                }
                const int j0 = 32 * g + 8 * qd;
                if (wave < 4) { *(LAS f32x4*)(lds + PL_KK + (i * 64 + j0) * 4) = acc[0]; *(LAS f32x4*)(lds + PL_KK + (i * 64 + j0 + 4) * 4) = acc[1]; }
                else {
#pragma unroll
                    for (int cb = 0; cb < 4; ++cb) {
                        const int dir = cb & 1, hv = hq * 2 + (cb >> 1);
                        const LAS float* gl = (const LAS float*)(lds + PL_G + cb * 512) + 64;
                        const float gi_ = gl[i]; const f32x4 gj0 = *(const LAS f32x4*)(gl + j0), gj1 = *(const LAS f32x4*)(gl + j0 + 4);
                        f32x4 o0, o1;
#pragma unroll
                        for (int r = 0; r < 4; ++r) { const int ja = j0 + r, jb = j0 + 4 + r; const bool ka = dir ? (ja >= i) : (ja <= i), kb = dir ? (jb >= i) : (jb <= i);
                            o0[r] = ka ? acc[0][r] * __expf(gi_ - gj0[r]) : 0.f; o1[r] = kb ? acc[1][r] * __expf(gi_ - gj1[r]) : 0.f; }
                        unsigned char* qki = (unsigned char*)c.ws + WS_IMGHD + (size_t)(((b * 68 + n) * 8 + hv) * 2 + dir) * IMGHD_STRIDE + ID_QK;
                        *(bf16x8*)(qki + i * 144 + j0 * 2) = pack8(o0, o1);
                    }
                }
            }
        }
        __syncthreads();
        if (wave < 4) {
            int dir = wave & 1, ln = lane; asm volatile("" : "+s"(dir), "+v"(ln));
            const LAS float* gl = (const LAS float*)(lds + PL_G + wave * 512);
            LAS unsigned char* tk = lds + (wave < 2 ? PL_T01 + wave * 18432 : PL_T23 + (wave - 2) * 18432);
            LAS float* Tf = (LAS float*)tk;
            const int q = ln >> 4, x = ln & 15;
#define TOKN(g_) (dir ? 63 - (g_) : (g_))
#define AFUN(gr_, gc_) (gl[TOKN(gr_)] * (*(const LAS float*)(lds + PL_KK + (TOKN(gr_) * 64 + TOKN(gc_)) * 4)) * __expf(gl[64 + TOKN(gr_)] - gl[64 + TOKN(gc_)]))
            {
                float Dc[16];
#pragma unroll
                for (int r = 0; r < 16; ++r) Dc[r] = (r == 0) ? ((x == 0) ? 1.f : 0.f) : 0.f;
#pragma unroll
                for (int r = 1; r < 16; ++r) {
                    float a = AFUN(16 * q + r, 16 * q + x);
                    a = (x < r) ? a : 0.f;
                    float s0 = 0.f, s1 = 0.f;
#pragma unroll
                    for (int m = 0; m < r; ++m) {
                        const float am = __uint_as_float((unsigned)__builtin_amdgcn_ds_bpermute(((ln & 48) + m) << 2, (int)__float_as_uint(a)));
                        if (m & 1) s1 += am * Dc[m]; else s0 += am * Dc[m];
                    }
                    Dc[r] = ((x == r) ? 1.f : 0.f) - (s0 + s1);
                }
#pragma unroll
                for (int r = 0; r < 16; ++r) Tf[(16 * q + r) * 64 + 16 * q + x] = Dc[r];
            }
            asm volatile("s_waitcnt lgkmcnt(0)" ::: "memory");
            f32x4 E10, E20, E21, E30, E31, E32;
#define EBLK(dst, r_, k_) do { dst = (f32x4){0.f, 0.f, 0.f, 0.f}; const f32x4 dr_ = *(const LAS f32x4*)(Tf + (16 * (r_) + x) * 64 + 16 * (r_) + 4 * q); \
                _Pragma("unroll") for (int s_ = 0; s_ < 4; ++s_) dst = __builtin_amdgcn_mfma_f32_16x16x4f32(AFUN(16 * (r_) + 4 * q + s_, 16 * (k_) + x), dr_[s_], dst, 0, 0, 0); } while (0)
            EBLK(E10, 1, 0); EBLK(E20, 2, 0); EBLK(E21, 2, 1); EBLK(E30, 3, 0); EBLK(E31, 3, 1); EBLK(E32, 3, 2);
#undef EBLK
#define TACC(acc, E_, k_, c_) do { _Pragma("unroll") for (int s_ = 0; s_ < 4; ++s_) acc = __builtin_amdgcn_mfma_f32_16x16x4f32(E_[s_], Tf[(16 * (k_) + 4 * q + s_) * 64 + 16 * (c_) + x], acc, 0, 0, 0); } while (0)
#define TSTORE(acc, r_, c_) do { _Pragma("unroll") for (int r2_ = 0; r2_ < 4; ++r2_) Tf[(16 * (r_) + 4 * q + r2_) * 64 + 16 * (c_) + x] = -acc[r2_]; } while (0)
            {
                f32x4 t10 = (f32x4){0.f, 0.f, 0.f, 0.f}, t21 = t10, t32 = t10;
                TACC(t10, E10, 0, 0); TACC(t21, E21, 1, 1); TACC(t32, E32, 2, 2);
                TSTORE(t10, 1, 0); TSTORE(t21, 2, 1); TSTORE(t32, 3, 2);
                asm volatile("s_waitcnt lgkmcnt(0)" ::: "memory");
                f32x4 t20 = (f32x4){0.f, 0.f, 0.f, 0.f}, t31 = t20;
                TACC(t20, E20, 0, 0); TACC(t20, E21, 1, 0); TACC(t31, E31, 1, 1); TACC(t31, E32, 2, 1);
                TSTORE(t20, 2, 0); TSTORE(t31, 3, 1);
                asm volatile("s_waitcnt lgkmcnt(0)" ::: "memory");
                f32x4 t30 = (f32x4){0.f, 0.f, 0.f, 0.f};
                TACC(t30, E30, 0, 0); TACC(t30, E31, 1, 0); TACC(t30, E32, 2, 0);
                TSTORE(t30, 3, 0);
                asm volatile("s_waitcnt lgkmcnt(0)" ::: "memory");
            }
#undef TACC
#undef TSTORE
#undef AFUN
            const int jn = TOKN(ln);
            const float gcj = gl[64 + jn], betaj = gl[jn];
            float Tc[64];
#pragma unroll
            for (int i = 0; i < 64; ++i) { const float v = Tf[i * 64 + ln]; Tc[i] = (i >= (ln & 48)) ? v : 0.f; }
            asm volatile("s_waitcnt lgkmcnt(0)" ::: "memory");
            const float sk_ = betaj * __expf(gcj), sv_ = betaj;
#pragma unroll
            for (int i = 0; i < 64; ++i) {
                const int in = TOKN(i);
                *(LAS u16*)(tk + in * 144 + jn * 2) = f2bf(Tc[i] * sk_);
                *(LAS u16*)(tk + 9216 + in * 144 + jn * 2) = f2bf(Tc[i] * sv_);
            }
#undef TOKN
        }
        __syncthreads();
        {
            const int cb = wave >> 1, typ = wave & 1, dir = cb & 1, hvl = cb >> 1, hv = hq * 2 + hvl, fr = lane & 15, qd = lane >> 4;
            const LAS unsigned char* tb = lds + (cb < 2 ? PL_T01 + cb * 18432 : PL_T23 + (cb - 2) * 18432) + typ * 9216;
            unsigned char* img = (unsigned char*)c.ws + WS_IMGHD + (size_t)(((b * 68 + n) * 8 + hv) * 2 + dir) * IMGHD_STRIDE;
            const int prm = 8 * (fr >> 2) + (fr & 3);
            bf16x8 tf[4][2];
#pragma unroll
            for (int it = 0; it < 4; ++it) { const int trow = typ ? (32 * (it >> 1) + prm + 4 * (it & 1)) : (it * 16 + fr);
#pragma unroll
                for (int ks = 0; ks < 2; ++ks) tf[it][ks] = frag_nat(tb + trow * 144 + ks * 64 + qd * 16); }
            const LAS unsigned char* xb = lds + (typ == 0 ? PL_KT : PL_VT + hvl * 128 * 144);
#pragma unroll
            for (int dg = 0; dg < 4; ++dg) {
                bf16x8 xf[2][2];
#pragma unroll
                for (int sub = 0; sub < 2; ++sub) { const int xrow = typ ? (32 * dg + 16 * sub + fr) : (32 * dg + prm + 4 * sub);
#pragma unroll
                    for (int ks = 0; ks < 2; ++ks) xf[sub][ks] = frag_nat(xb + xrow * 144 + ks * 64 + qd * 16); }
                if (typ == 0) {
#pragma unroll
                    for (int it = 0; it < 4; ++it) {
                        f32x4 a0 = (f32x4){0.f, 0.f, 0.f, 0.f}, a1 = a0;
#pragma unroll
                        for (int ks = 0; ks < 2; ++ks) { a0 = mfma16(xf[0][ks], tf[it][ks], a0); a1 = mfma16(xf[1][ks], tf[it][ks], a1); }
                        *(bf16x8*)(img + ID_W + (it * 16 + fr) * 272 + (32 * dg + 8 * qd) * 2) = pack8(-a0, -a1);
                    }
                } else {
#pragma unroll
                    for (int sub2 = 0; sub2 < 2; ++sub2)
#pragma unroll
                        for (int h = 0; h < 2; ++h) {
                            f32x4 a0 = (f32x4){0.f, 0.f, 0.f, 0.f}, a1 = a0;
#pragma unroll
                            for (int ks = 0; ks < 2; ++ks) { a0 = mfma16(tf[2 * h][ks], xf[sub2][ks], a0); a1 = mfma16(tf[2 * h + 1][ks], xf[sub2][ks], a1); }
                            *(bf16x8*)(img + ID_UT + (32 * dg + 16 * sub2 + fr) * 128 + (32 * h + 8 * qd) * 2) = pack8(a0, a1);
                        }
                }
            }
        }
        if (mode) asm volatile("s_waitcnt vmcnt(0)" ::: "memory");
        __syncthreads();
        if (mode && tid == 0) {
            __builtin_amdgcn_fence(__ATOMIC_RELEASE, "agent");
            __hip_atomic_store((unsigned*)c.ws + DEF_FLAG(m), 1u, __ATOMIC_RELEASE, __HIP_MEMORY_SCOPE_AGENT);
        }
    }
}

constexpr int SB_W = 0, SB_QK = 17408, SB_G = 26624, SB_Q = 27648, SB_KT = 45056, SB_BYTES = 63488;
DI void ph_gdn_scan(const Ctx& c, const Blk& B, unsigned char* lds_raw, int first) {
    const int me = B.bid - first;
    if (me < 0 || me >= 128) return;
    const int item = (me & 7) + 8 * (me >> 4), half = (me >> 3) & 1;
    LAS unsigned char* lds = (LAS unsigned char*)lds_raw;
    const int dir = item & 1, hv = (item >> 1) & 7, b = item >> 4, hq = hv >> 1;
    const bool cw = B.wave < 4;
    const int tid = B.tid, lane = B.lane, wave = B.wave, fr = lane & 15, qd = lane >> 4;
    const unsigned char* imgh0 = (const unsigned char*)c.ws + WS_IMGH; const unsigned char* imghd0 = (const unsigned char*)c.ws + WS_IMGHD;
    u16* O = (u16*)(c.ws + WS_O2);
#define CHUNK_OF(s) (dir ? ((s) < 4 ? 3 - (s) : 71 - (s)) : (s))
#define IMGH_OF(n) (imgh0 + (size_t)((b * 68 + (n)) * 4 + hq) * IMGH_STRIDE)
#define IMGHD_OF(n) (imghd0 + (size_t)(((b * 68 + (n)) * 8 + hv) * 2 + dir) * IMGHD_STRIDE)
#define DMA_STEP(n, buf) do { if (wave >= 4 && wave < 7) { const unsigned char* s_hd = IMGHD_OF(n); const unsigned char* s_h = IMGH_OF(n); \
        _Pragma("unroll") for (int it_ = 0; it_ < 21; ++it_) { const int p_ = it_ * 3 + (wave - 4); \
            if (p_ < 27) __builtin_amdgcn_global_load_lds((const unsigned*)(s_hd + p_ * 1024 + lane * 16), (LAS unsigned*)(lds + (buf) * SB_BYTES + p_ * 1024), 16, 0, 0); \
            else if (p_ < 62) __builtin_amdgcn_global_load_lds((const unsigned*)(s_h + (p_ - 27) * 1024 + lane * 16), (LAS unsigned*)(lds + (buf) * SB_BYTES + p_ * 1024), 16, 0, 0); } } } while (0)
#define STEP_BARRIER() do { if (wave == 7) asm volatile("s_waitcnt lgkmcnt(0)" ::: "memory"); else asm volatile("s_waitcnt vmcnt(0) lgkmcnt(0)" ::: "memory"); \
        __builtin_amdgcn_s_barrier(); asm volatile("" ::: "memory"); } while (0)
    f32x4 S[8];
#pragma unroll
    for (int dt = 0; dt < 8; ++dt) S[dt] = (f32x4){0.f, 0.f, 0.f, 0.f};
    const int dvc = half * 64 + (wave & 3) * 16 + fr;
    unsigned long long ucp[4];
#define REG_LOAD(n) do { const unsigned char* s_hd = IMGHD_OF(n); \
        _Pragma("unroll") for (int it_ = 0; it_ < 4; ++it_) ucp[it_] = *(const unsigned long long*)(s_hd + ID_UT + dvc * 128 + (it_ * 16 + qd * 4) * 2); } while (0)
    constexpr int OSTG = 2 * SB_BYTES + 1024;
#define OST_STORE(nprev, sb) do { if ((nprev) >= 4) { u16* orow_ = O + ((size_t)dir * NT + (size_t)b * L + (size_t)((nprev) - 4) * 64) * 1024 + hv * 128 + half * 64; \
        _Pragma("unroll") for (int j_ = 0; j_ < 8; ++j_) { const int ix_ = lane + 64 * j_, row_ = ix_ >> 3, ch_ = ix_ & 7; \
            *(pg::u32x4*)(orow_ + (size_t)row_ * 1024 + ch_ * 8) = *(const LAS pg::u32x4*)(lds + OSTG + (sb) * 8192 + row_ * 128 + ch_ * 16); } } } while (0)
    DMA_STEP(CHUNK_OF(0), 0);
    if (cw) REG_LOAD(CHUNK_OF(0));
    STEP_BARRIER();
    const int sdef = dir ? 71 - (DEF_N0(b) + 3) : DEF_N0(b);
    for (int s = 0; s < 68; ++s) {
        const int n = CHUNK_OF(s), buf = s & 1;
        const LAS unsigned char* lb = lds + buf * SB_BYTES;
        f32x4 u[4];
#pragma unroll
        for (int it = 0; it < 4; ++it) {
            const unsigned lo = (unsigned)ucp[it], hi = (unsigned)(ucp[it] >> 32);
            u[it] = (f32x4){__uint_as_float(lo << 16), __uint_as_float(lo & 0xffff0000u), __uint_as_float(hi << 16), __uint_as_float(hi & 0xffff0000u)};
        }
        if (wave == 7 && s > 0) OST_STORE(CHUNK_OF(s - 1), (s - 1) & 1);
        if (s == sdef - 2) {
            if (wave == 7) {
                const unsigned* fl = (const unsigned*)c.ws + DEF_FLAG(b * 16 + hq);
                while ((__hip_atomic_load(fl, __ATOMIC_RELAXED, __HIP_MEMORY_SCOPE_AGENT) & __hip_atomic_load(fl + 64, __ATOMIC_RELAXED, __HIP_MEMORY_SCOPE_AGENT)
                        & __hip_atomic_load(fl + 128, __ATOMIC_RELAXED, __HIP_MEMORY_SCOPE_AGENT) & __hip_atomic_load(fl + 192, __ATOMIC_RELAXED, __HIP_MEMORY_SCOPE_AGENT)) == 0u) __builtin_amdgcn_s_sleep(2);
                __builtin_amdgcn_fence(__ATOMIC_ACQUIRE, "agent");
            }
        }
        if (s + 1 < 68) { const int n2 = CHUNK_OF(s + 1); DMA_STEP(n2, buf ^ 1); if (cw) REG_LOAD(n2); }
        if (cw) {
#define SBAR __builtin_amdgcn_sched_barrier(0)
#define LD_ROWS4(dst, base, rt0) do { _Pragma("unroll") for (int r_ = 0; r_ < 2; ++r_) _Pragma("unroll") for (int ks_ = 0; ks_ < 4; ++ks_) \
            dst[r_ * 4 + ks_] = frag_perm(lb + (base) + (((rt0) + r_) * 16 + fr) * 272 + (ks_ * 32 + qd * 4) * 2); } while (0)
#define LD_ROWS2(dst, base, rt0) do { _Pragma("unroll") for (int r_ = 0; r_ < 4; ++r_) _Pragma("unroll") for (int ks_ = 0; ks_ < 2; ++ks_) \
            dst[r_ * 2 + ks_] = frag_perm(lb + (base) + (((rt0) + r_) * 16 + fr) * 144 + (ks_ * 32 + qd * 4) * 2); } while (0)
        const LAS float* gb = (const LAS float*)(lb + SB_G);
        bf16x8 sf[4], fa[8], fb[8], fc[8];
#pragma unroll
        for (int ks = 0; ks < 4; ++ks) sf[ks] = pack8(S[2 * ks], S[2 * ks + 1]);
        f32x4 o[4];
        LD_ROWS4(fa, SB_W, 0);
        LD_ROWS4(fb, SB_W, 2);
        SBAR;
        LD_ROWS4(fc, SB_Q, 0);
#pragma unroll
        for (int r = 0; r < 2; ++r)
#pragma unroll
            for (int ks = 0; ks < 4; ++ks) u[r] = mfma16(fa[r * 4 + ks], sf[ks], u[r]);
        SBAR;
        LD_ROWS4(fa, SB_Q, 2);
#pragma unroll
        for (int r = 0; r < 2; ++r)
#pragma unroll
            for (int ks = 0; ks < 4; ++ks) u[2 + r] = mfma16(fb[r * 4 + ks], sf[ks], u[2 + r]);
        SBAR;
        LD_ROWS2(fb, SB_QK, 0);
#pragma unroll
        for (int r = 0; r < 2; ++r) { o[r] = (f32x4){0.f, 0.f, 0.f, 0.f};
#pragma unroll
            for (int ks = 0; ks < 4; ++ks) o[r] = mfma16(fc[r * 4 + ks], sf[ks], o[r]); }
        bf16x8 uf[2], upf[2];
        {
            f32x4 ek[4];
#pragma unroll
            for (int it = 0; it < 4; ++it) ek[it] = *(const LAS f32x4*)(gb + 64 + it * 16 + qd * 4);
#pragma unroll
            for (int ks = 0; ks < 2; ++ks) { uf[ks] = pack8(u[2 * ks], u[2 * ks + 1]); upf[ks] = pack8(u[2 * ks] * ek[2 * ks], u[2 * ks + 1] * ek[2 * ks + 1]); }
        }
        SBAR;
        LD_ROWS2(fc, SB_KT, 0);
#pragma unroll
        for (int r = 0; r < 2; ++r) { o[2 + r] = (f32x4){0.f, 0.f, 0.f, 0.f};
#pragma unroll
            for (int ks = 0; ks < 4; ++ks) o[2 + r] = mfma16(fa[r * 4 + ks], sf[ks], o[2 + r]); }
        SBAR;
        const float ege = gb[128];
        LD_ROWS2(fa, SB_KT, 4);
#pragma unroll
        for (int it = 0; it < 4; ++it) { o[it] *= *(const LAS f32x4*)(gb + it * 16 + qd * 4);
#pragma unroll
            for (int ks = 0; ks < 2; ++ks) o[it] = mfma16(fb[it * 2 + ks], uf[ks], o[it]); }
        SBAR;
#pragma unroll
        for (int dt = 0; dt < 4; ++dt) { S[dt] *= ege;
#pragma unroll
            for (int ks = 0; ks < 2; ++ks) S[dt] = mfma16(fc[dt * 2 + ks], upf[ks], S[dt]); }
        SBAR;
#pragma unroll
        for (int dt = 0; dt < 4; ++dt) { S[4 + dt] *= ege;
#pragma unroll
            for (int ks = 0; ks < 2; ++ks) S[4 + dt] = mfma16(fa[dt * 2 + ks], upf[ks], S[4 + dt]); }
#undef SBAR
#undef LD_ROWS4
#undef LD_ROWS2
        if (n >= 4) {
            LAS unsigned char* sg = lds + OSTG + (s & 1) * 8192 + ((wave & 3) * 16 + fr) * 2;
#pragma unroll
            for (int it = 0; it < 4; ++it)
#pragma unroll
                for (int r = 0; r < 4; ++r) *(LAS u16*)(sg + (it * 16 + qd * 4 + r) * 128) = f2bf(o[it][r]);
        }
        }
        STEP_BARRIER();
    }
    if (wave == 7) OST_STORE(CHUNK_OF(67), 67 & 1);
    asm volatile("s_waitcnt vmcnt(0)" ::: "memory");
#undef CHUNK_OF
#undef IMGH_OF
#undef IMGHD_OF
#undef DMA_STEP
#undef REG_LOAD
#undef OST_STORE
#undef STEP_BARRIER
}

DI void ph_mergeprep2(const Ctx& c, const Blk& B) {
    const u16* O = (const u16*)(c.ws + WS_O2); const u16* SZ = (const u16*)(c.ws + WS_SZ); u16* OB = (u16*)(c.ws + WS_OB);
    for (int row = B.bid * 8 + B.wave; row < NT; row += B.G * 8) {
        const int c0 = B.lane * 16;
        const uint4 a0 = *(const uint4*)(O + (size_t)row * 1024 + c0), a1 = *(const uint4*)(O + (size_t)row * 1024 + c0 + 8);
        const uint4 b0 = *(const uint4*)(O + ((size_t)NT + row) * 1024 + c0), b1 = *(const uint4*)(O + ((size_t)NT + row) * 1024 + c0 + 8);
        const uint4 z0 = *(const uint4*)(SZ + (size_t)row * 1024 + c0), z1 = *(const uint4*)(SZ + (size_t)row * 1024 + c0 + 8);
        const unsigned aw[8] = {a0.x, a0.y, a0.z, a0.w, a1.x, a1.y, a1.z, a1.w}, bw[8] = {b0.x, b0.y, b0.z, b0.w, b1.x, b1.y, b1.z, b1.w}, zw[8] = {z0.x, z0.y, z0.z, z0.w, z1.x, z1.y, z1.z, z1.w};
        float o[16]; float ss = 0.f;
#pragma unroll
        for (int i = 0; i < 8; ++i) { o[2 * i] = __uint_as_float(aw[i] << 16) + __uint_as_float(bw[i] << 16); o[2 * i + 1] = __uint_as_float(aw[i] & 0xffff0000u) + __uint_as_float(bw[i] & 0xffff0000u); ss += o[2 * i] * o[2 * i] + o[2 * i + 1] * o[2 * i + 1]; }
#ifdef DBG_SANITIZE
        ss = 0.f;
#pragma unroll
        for (int i = 0; i < 16; ++i) { if (!(fabsf(o[i]) < 1e30f)) o[i] = 0.f; ss += o[i] * o[i]; }
#endif
        ss += __shfl_xor(ss, 1); ss += __shfl_xor(ss, 2); ss += __shfl_xor(ss, 4);
        const float rs = rsqrtf(ss * (1.f / 128.f) + EPS);
        unsigned ow[8];
#pragma unroll
        for (int i = 0; i < 8; ++i) { const int ch = (c0 + 2 * i) & 127;
            ow[i] = pg::cvt_pk_bf16(o[2 * i] * rs * c.gdn_norm_g[ch] * __uint_as_float(zw[i] << 16), o[2 * i + 1] * rs * c.gdn_norm_g[ch + 1] * __uint_as_float(zw[i] & 0xffff0000u)); }
        *(uint4*)(OB + (size_t)row * 1024 + c0) = make_uint4(ow[0], ow[1], ow[2], ow[3]); *(uint4*)(OB + (size_t)row * 1024 + c0 + 8) = make_uint4(ow[4], ow[5], ow[6], ow[7]);
    }
}

constexpr size_t WS_WRT = WS_MOD + 256 * 1024;
constexpr size_t WS_RC = WS_MOD + 128 * 1024;
DI void ph_router_const(const Ctx& c, const Blk& B) {
    if (B.bid >= 16) {
        if (B.bid < 80) {
            float* WRT = (float*)(c.ws + WS_WRT);
#pragma unroll
            for (int j = 0; j < 4; ++j) { const int idx = (B.bid - 16) * 512 + B.tid + 32768 * j, b = idx >> 15, k = (idx >> 5) & 1023, e = idx & 31;
                WRT[(size_t)(b * 32 + e) * 1024 + k] = c.w_router[k * 32 + e] * (c.norm2_g[k] * (1.f + ((const float*)(c.ws + WS_MOD))[b * 6144 + 4096 + k])); }
        }
        return;
    }
    const int idx = B.bid * 8 + B.wave, b = idx >> 5, e = idx & 31;
    const float* sh = (const float*)(c.ws + WS_MOD) + b * 6144 + 3072;
    float s = 0.f;
#pragma unroll 4
    for (int j = 0; j < 16; ++j) { const int k = B.lane + 64 * j; s += sh[k] * c.w_router[(size_t)k * 32 + e]; }
    s = wave_sum(s);
    if (B.lane == 0) ((float*)(c.ws + WS_RC))[idx] = s + c.b_router[e];
}
DI void ph_router_fast(const Ctx& c, const Blk& B, unsigned char* lds_raw) {
    const float* X1 = c.out; const float* MOD = (const float*)(c.ws + WS_MOD); u16* H2 = (u16*)(c.ws + WS_H2); const float* SSP = (const float*)(c.ws + WS_SSP);
    int* cnt = (int*)(c.ws + WS_CTL); int* TOKE = (int*)(c.ws + WS_TOKE); float* WTE = (float*)(c.ws + WS_WTE); int* TOPE = (int*)(c.ws + WS_TOPE); int* TOPP = (int*)(c.ws + WS_TOPP);
    LAS unsigned* arr = (LAS unsigned*)((LAS unsigned char*)lds_raw + 133120);
    const int lane = B.lane, i = lane & 15, kq = lane >> 4;
    for (int tb = B.bid; tb < NT / 64; tb += B.G) {
        __syncthreads();
        if (B.tid < 4) arr[B.tid] = 0u;
        __syncthreads();
        const int tok0 = tb * 64, b = tok0 / L;
        const float* g2 = c.norm2_g; const float* sh = MOD + b * 6144 + 3072; const float* sc = MOD + b * 6144 + 4096;
        if (B.wave >= 4) {
            const int r0 = tok0 + (B.wave - 4) * 16;
            f32x4 G[4], S[4];
#pragma unroll
            for (int j = 0; j < 4; ++j) { const f32x4 g = *(const f32x4*)(g2 + (lane + 64 * j) * 4), s = *(const f32x4*)(sc + (lane + 64 * j) * 4); G[j] = g * (s + 1.f); S[j] = *(const f32x4*)(sh + (lane + 64 * j) * 4); }
            float rsd;
            { const float* sp = SSP + (size_t)(4 * kq) * NT + r0 + i; float ssv = ((sp[0] + sp[NT]) + sp[2 * NT]) + sp[3 * NT];
              ssv += __shfl_xor(ssv, 16); ssv += __shfl_xor(ssv, 32); rsd = rsqrtf(ssv * (1.f / D) + EPS); }
#pragma unroll
            for (int rb = 0; rb < 16; rb += 8) {
                f32x4 v[8][4];
#pragma unroll
                for (int r = 0; r < 8; ++r)
#pragma unroll
                    for (int j = 0; j < 4; ++j) v[r][j] = *(const f32x4*)(X1 + (size_t)(r0 + rb + r) * D + (lane + 64 * j) * 4);
#pragma unroll
                for (int r = 0; r < 8; ++r) {
                    const float rstd = __builtin_bit_cast(float, __builtin_amdgcn_readlane(__builtin_bit_cast(int, rsd), rb + r));
#pragma unroll
                    for (int j = 0; j < 4; ++j) *(unsigned long long*)(H2 + (size_t)(r0 + rb + r) * D + (lane + 64 * j) * 4) = pack4(v[r][j] * rstd * G[j] + S[j]);
                }
            }
            continue;
        }
        const int w = B.wave, ks = w * 256;
        LAS float* xs = (LAS float*)lds_raw + w * 4160;
        LAS unsigned* hist = (LAS unsigned*)(xs + 3760);
        if (lane < 32) hist[lane] = 0u;
        float wa[64], wb[64];
        { const float* wt = (const float*)(c.ws + WS_WRT) + (size_t)(b * 32 + i) * 1024 + ks + 16 * kq;
#pragma unroll
          for (int c4 = 0; c4 < 4; ++c4)
#pragma unroll
            for (int s4 = 0; s4 < 4; ++s4) {
                const float4 A = *(const float4*)(wt + 64 * c4 + 4 * s4), Bv = *(const float4*)(wt + 16 * 1024 + 64 * c4 + 4 * s4);
                const int o = (c4 * 4 + s4) * 4;
                wa[o] = A.x; wa[o + 1] = A.y; wa[o + 2] = A.z; wa[o + 3] = A.w; wb[o] = Bv.x; wb[o + 1] = Bv.y; wb[o + 2] = Bv.z; wb[o + 3] = Bv.w;
            } }
        const float* xu = X1 + (size_t)tok0 * D + ks;
        const int lo = (lane >> 4) * D + (lane & 15) * 4;
        constexpr int NPF = 2;
        f32x4 xr[NPF][4];
#pragma unroll
        for (int p = 0; p < NPF; ++p)
#pragma unroll
            for (int t = 0; t < 4; ++t) xr[p][t] = *(const f32x4*)(xu + ((16 * (p >> 2) + 4 * t) * D + 64 * (p & 3)) + lo);
        f32x4 a0 = (f32x4){0.f, 0.f, 0.f, 0.f}, a1 = (f32x4){0.f, 0.f, 0.f, 0.f};
#pragma unroll
        for (int p = 0; p < 16; ++p) {
            const int g = p >> 2, c4 = p & 3;
#pragma unroll
            for (int t = 0; t < 4; ++t) *(LAS f32x4*)(xs + (4 * t + (lane >> 4)) * 68 + (lane & 15) * 4) = xr[p % NPF][t];
            if (p + NPF < 16) {
#pragma unroll
                for (int t = 0; t < 4; ++t) xr[p % NPF][t] = *(const f32x4*)(xu + ((16 * ((p + NPF) >> 2) + 4 * t) * D + 64 * ((p + NPF) & 3)) + lo);
            }
            asm volatile("s_waitcnt lgkmcnt(0)" ::: "memory");
#pragma unroll
            for (int s4 = 0; s4 < 4; ++s4) {
                const f32x4 v = *(const LAS f32x4*)(xs + i * 68 + kq * 16 + 4 * s4);
#pragma unroll
                for (int q = 0; q < 4; ++q) {
                    a0 = __builtin_amdgcn_mfma_f32_16x16x4f32(v[q], wa[(c4 * 4 + s4) * 4 + q], a0, 0, 0, 0);
                    a1 = __builtin_amdgcn_mfma_f32_16x16x4f32(v[q], wb[(c4 * 4 + s4) * 4 + q], a1, 0, 0, 0);
                }
            }
            asm volatile("" ::: "memory");
            if (c4 == 3) {
                LAS float* P = (LAS float*)lds_raw + g * 4160 + 1088 + w * 528;
#pragma unroll
                for (int r = 0; r < 4; ++r) { P[(4 * kq + r) * 33 + i] = a0[r]; P[(4 * kq + r) * 33 + 16 + i] = a1[r]; }
                asm volatile("s_waitcnt lgkmcnt(0)" ::: "memory");
                if (lane == 0) __hip_atomic_fetch_add(arr + g, 1u, __ATOMIC_RELEASE, __HIP_MEMORY_SCOPE_WORKGROUP);
                a0 = (f32x4){0.f, 0.f, 0.f, 0.f}; a1 = (f32x4){0.f, 0.f, 0.f, 0.f};
            }
        }
        while (__hip_atomic_load(arr + w, __ATOMIC_ACQUIRE, __HIP_MEMORY_SCOPE_WORKGROUP) < 4u) __builtin_amdgcn_s_sleep(1);
        asm volatile("s_waitcnt lgkmcnt(0)" ::: "memory");
        const int row0 = tok0 + 16 * w;
        float ssv;
        { const float* sp = SSP + (size_t)(4 * kq) * NT + row0 + i; ssv = ((sp[0] + sp[NT]) + sp[2 * NT]) + sp[3 * NT]; }
        ssv += __shfl_xor(ssv, 16); ssv += __shfl_xor(ssv, 32);
        const float rstd = rsqrtf(ssv * (1.f / D) + EPS);
        LAS float* Pm = xs + 1088;
        LAS float* lg = xs + 3200;
        const float* RC = (const float*)(c.ws + WS_RC) + b * 32;
#pragma unroll
        for (int e8 = 0; e8 < 8; ++e8) { const int e = 8 * kq + e8, o = i * 33 + e;
            lg[i * 34 + e] = (((Pm[o] + Pm[528 + o]) + Pm[1056 + o]) + Pm[1584 + o]) * rstd + RC[e]; }
        asm volatile("s_waitcnt lgkmcnt(0)" ::: "memory");
        int sidx[4] = {0, 0, 0, 0}, slp[4] = {0, 0, 0, 0}, strow = 0; float sw[4] = {0.f, 0.f, 0.f, 0.f};
        if (B.lane < 16) {
            float l_[32];
#pragma unroll
            for (int e = 0; e < 32; e += 2) { const pg::f32x2_ t = *(const LAS pg::f32x2_*)(lg + B.lane * 34 + e); l_[e] = t[0]; l_[e + 1] = t[1]; }
            int idx[4]; float val[4];
#pragma unroll
            for (int j = 0; j < 4; ++j) {
                float best = -3.0e38f; int bi = 0;
#pragma unroll
                for (int e = 0; e < 32; ++e) { const bool taken = (j > 0 && idx[0] == e) || (j > 1 && idx[1] == e) || (j > 2 && idx[2] == e); if (!taken && l_[e] > best) { best = l_[e]; bi = e; } }
                idx[j] = bi; val[j] = best;
            }
            float wv[4], den = 0.f;
#pragma unroll
            for (int j = 0; j < 4; ++j) { wv[j] = expf(val[j] - val[0]); den += wv[j]; }
            int lp[4];
#pragma unroll
            for (int j = 0; j < 4; ++j) lp[j] = (int)__hip_atomic_fetch_add((LAS unsigned*)hist + idx[j], 1u, __ATOMIC_RELAXED, __HIP_MEMORY_SCOPE_WORKGROUP);
            asm volatile("s_waitcnt lgkmcnt(0)" ::: "memory");
            sidx[0] = idx[0]; sidx[1] = idx[1]; sidx[2] = idx[2]; sidx[3] = idx[3]; slp[0] = lp[0]; slp[1] = lp[1]; slp[2] = lp[2]; slp[3] = lp[3];
            sw[0] = wv[0] / den; sw[1] = wv[1] / den; sw[2] = wv[2] / den; sw[3] = wv[3] / den; strow = row0 + B.lane;
        }
        asm volatile("s_waitcnt lgkmcnt(0)" ::: "memory");
        if (B.lane < 32) { const unsigned n = hist[B.lane]; unsigned base = 0u; if (n) base = (unsigned)atomicAdd(&cnt[64 * B.lane], (int)n); hist[32 + B.lane] = base; }
        asm volatile("s_waitcnt vmcnt(0) lgkmcnt(0)" ::: "memory");
        if (B.lane < 16) {
#pragma unroll
            for (int j = 0; j < 4; ++j) {
                const int e = sidx[j]; const int pos = (int)hist[32 + e] + slp[j];
                TOKE[e * CAP + pos] = strow; WTE[e * CAP + pos] = sw[j]; TOPE[strow * 4 + j] = e; TOPP[strow * 4 + j] = pos;
            }
        }
        asm volatile("s_waitcnt lgkmcnt(0)" ::: "memory");
    }
}


DI void ph_dftm2(const Ctx& c, const Blk& B, float* lds) {
    u16* CS = (u16*)c.out;
    const size_t n8 = (size_t)2 * 2048 * 2048 / 8;
    for (size_t i = (size_t)B.bid * 512 + B.tid; i < n8; i += (size_t)B.G * 512) {
        const int which = (int)(i >> 19), r = (int)(i & 524287), k = r >> 8, l0 = (r & 255) * 8, ph = which ? 3072 : 0;
        unsigned w[4];
#pragma unroll
        for (int q = 0; q < 4; ++q) {
            const float lo = cos_rev(((k * (l0 + 2 * q)) + ph) & 4095, 1.f / 4096.f), hi = cos_rev(((k * (l0 + 2 * q + 1)) + ph) & 4095, 1.f / 4096.f);
            w[q] = (unsigned)f2bf(lo) | ((unsigned)f2bf(hi) << 16);
        }
        *(uint4*)(CS + i * 8) = make_uint4(w[0], w[1], w[2], w[3]);
    }
    __syncthreads();
}
DI void ph_dft_edge(const Ctx& c, const Blk& B) {
    const u16* WFT = (const u16*)(c.ws + WS_WFT); const u16* FE = (const u16*)((const char*)c.out + FE_OUT_OFF); float* NYQ = (float*)(c.ws + WS_NYQ);
    for (int n = B.bid * 8 + B.wave; n < 2048; n += B.G * 8) {
        const int b = n >> 9, gm = n & 511;
        const u16* ur = (const u16*)(c.ws + WS_NYQ + 16384) + (size_t)b * D; const u16* wr = WFT + (size_t)gm * D;
        float f = 0.f, nyq = 0.f;
#pragma unroll
        for (int j = 0; j < 2; ++j) {
            const uint4 a = *(const uint4*)(ur + (B.lane + 64 * j) * 8), w = *(const uint4*)(wr + (B.lane + 64 * j) * 8);
            const unsigned aw[4] = {a.x, a.y, a.z, a.w}, ww[4] = {w.x, w.y, w.z, w.w};
#pragma unroll
            for (int q = 0; q < 4; ++q) f += __uint_as_float(aw[q] << 16) * __uint_as_float(ww[q] << 16) + __uint_as_float(aw[q] & 0xffff0000u) * __uint_as_float(ww[q] & 0xffff0000u);
        }
#pragma unroll
        for (int j = 0; j < 4; ++j) {
            const uint4 e = *(const uint4*)(FE + (size_t)n * 4096 + (B.lane + 64 * j) * 8);
            const unsigned ew[4] = {e.x, e.y, e.z, e.w};
#pragma unroll
            for (int q = 0; q < 4; ++q) nyq += __uint_as_float(ew[q] << 16) - __uint_as_float(ew[q] & 0xffff0000u);
        }
        f = wave_sum(f); nyq = wave_sum(nyq);
        if (B.lane == 0) { NYQ[n] = nyq + f; NYQ[2048 + n] = f; }
    }
}
struct SchedDFT2 {
    const char* CS; const char* FE; int c, first;
    DI bool next(int i, pg::Unit& u) const {
        const int me = c - first; if (i != 0 || me < 0 || me >= 128) return false;
        const int kind = me >> 6, idx = me & 63;
        u.pm = idx >> 3; u.pn = idx & 7; u.kind = kind; u.ex = 0; u.nt = 32;
        const char* a = CS + (size_t)kind * 2048 * 4096 + (size_t)u.pm * 256 * 4096; const char* b = FE + (size_t)u.pn * 256 * 8192 + (size_t)kind * 4096;
        u.a0 = a; u.a1 = a + 128 * 4096; u.b0 = b; u.b1 = b + 128 * 8192; u.v00 = u.v01 = u.v10 = u.v11 = 0u;
        return true;
    }
};
struct EpiDFT2 {
    float* PCS;
    DI void operator()(const pg::f32x4 (&acc)[2][2][4][2], const pg::Unit& u, int wr, int wc, int fr, int fq) const {
        float* base = PCS + (size_t)u.kind * 2048 * 2048 + (size_t)u.pm * 256 * 2048 + u.pn * 256 + wc * 32 + 4 * fq;
#pragma unroll
        for (int ai = 0; ai < 2; ++ai)
#pragma unroll
            for (int m = 0; m < 4; ++m) { float* rowp = base + (size_t)(ai * 128 + wr * 64 + m * 16 + fr) * 2048;
#pragma unroll
                for (int bj = 0; bj < 2; ++bj)
#pragma unroll
                    for (int n = 0; n < 2; ++n) *(pg::f32x4*)(rowp + bj * 128 + n * 16) = acc[ai][bj][m][n]; }
    }
};
DI void ph_dft2(const Ctx& c, const Blk& B, unsigned char* lds_raw, int first) {
    SchedDFT2 S{(const char*)c.out, (const char*)c.out + FE_OUT_OFF, B.bid, first};
    EpiDFT2 E{(float*)((char*)c.out + 16 * MiB)};
    pg::gemm_phase<false, false>((LAS unsigned char*)lds_raw, B.tid, 2048, 4096, S, E);
}
DI void ph_dft_combine(const Ctx& c, const Blk& B) {
    const float* PC = (const float*)((const char*)c.out + 16 * MiB); const float* PS = PC + (size_t)2048 * 2048; const float* NYQ = (const float*)(c.ws + WS_NYQ);
    u16* FM = (u16*)(c.ws + WS_FM2);
    const float scale = 1.f / 724.0773439350247f;
    for (int task = B.bid * 8 + B.wave; task < 4 * 2049; task += B.G * 8) {
        const int b = task / 2049, kk = task % 2049, n0 = b * 512 + B.lane * 8;
        float y0[8], y1[8];
        if (kk == 2048) {
#pragma unroll
            for (int j = 0; j < 8; ++j) y0[j] = NYQ[n0 + j];
        } else {
            const float sg = (kk & 1) ? -1.f : 1.f;
#pragma unroll
            for (int h = 0; h < 2; ++h) {
                const float4 pc = *(const float4*)(PC + (size_t)kk * 2048 + n0 + 4 * h), ps = *(const float4*)(PS + (size_t)kk * 2048 + n0 + 4 * h), f = *(const float4*)(NYQ + 2048 + n0 + 4 * h);
                const float pcv[4] = {pc.x, pc.y, pc.z, pc.w}, psv[4] = {ps.x, ps.y, ps.z, ps.w}, fv[4] = {f.x, f.y, f.z, f.w};
#pragma unroll
                for (int j = 0; j < 4; ++j) { const float base = pcv[j] + sg * fv[j]; y0[4 * h + j] = base - psv[j]; y1[4 * h + j] = base + psv[j]; }
            }
        }
        *(uint4*)(FM + ((size_t)b * 4096 + kk) * 512 + B.lane * 8) = make_uint4(pg::cvt_pk_bf16(y0[0] * scale, y0[1] * scale), pg::cvt_pk_bf16(y0[2] * scale, y0[3] * scale), pg::cvt_pk_bf16(y0[4] * scale, y0[5] * scale), pg::cvt_pk_bf16(y0[6] * scale, y0[7] * scale));
        if (kk >= 1 && kk <= 2047)
            *(uint4*)(FM + ((size_t)b * 4096 + (4096 - kk)) * 512 + B.lane * 8) = make_uint4(pg::cvt_pk_bf16(y1[0] * scale, y1[1] * scale), pg::cvt_pk_bf16(y1[2] * scale, y1[3] * scale), pg::cvt_pk_bf16(y1[4] * scale, y1[5] * scale), pg::cvt_pk_bf16(y1[6] * scale, y1[7] * scale));
    }
}

#define XB_TMO      128
#define XB_XCNT(j)  (256  + 64 * (j))
#define XB_XSUB(j)  (1280 + 64 * (j))
#define XB_XGEN(j)  (2304 + 64 * (j))
#define XB_TOP      3328
#define XB_TOPGEN   3392
#define XB_SPIN_CAP (1u << 18)
constexpr int XB_BASE = 8192;
constexpr int XB_LDS_OFF = 147456;
DI unsigned xb_ld(unsigned* p)              { return __hip_atomic_load(p, __ATOMIC_RELAXED, __HIP_MEMORY_SCOPE_AGENT); }
DI unsigned xb_add(unsigned* p, unsigned v) { return __hip_atomic_fetch_add(p, v, __ATOMIC_RELAXED, __HIP_MEMORY_SCOPE_AGENT); }
DI unsigned xb_xcc_id() { return (unsigned)__builtin_amdgcn_s_getreg((3 << 11) | 20) & 0xFu; }
#define XB_SPIN(cond, bar) do { unsigned _sp = 0; while (cond) { __builtin_amdgcn_s_sleep(1); \
    if ((++_sp & 255u) == 0u) { if (xb_ld(&(bar)[XB_TMO])) break; if (_sp > XB_SPIN_CAP) { atomicAdd(&(bar)[XB_TMO], 1u); break; } } } } while (0)
DI void xcd_barrier_complete(unsigned* bar, unsigned x, unsigned& nloc, unsigned& nx) {
    const unsigned G = gridDim.x;
    unsigned sum, cnt, mine, sp = 0u;
    for (;;) {
        sum = 0u; cnt = 0u; mine = 0u;
#pragma unroll
        for (unsigned j = 0; j < 16; ++j) { const unsigned c = xb_ld(&bar[XB_XCNT(j)]); sum += c; cnt += (c > 0u) ? 1u : 0u; mine = (j == x) ? c : mine; }
        if (sum == G) break;
        __builtin_amdgcn_s_sleep(1);
        if ((++sp & 255u) == 0u) { if (xb_ld(&bar[XB_TMO])) break; if (sp > XB_SPIN_CAP) { atomicAdd(&bar[XB_TMO], 1u); break; } }
    }
    nloc = mine > 0u ? mine : 1u; nx = cnt > 0u ? cnt : 1u;
}
DI void xcd_barrier(unsigned* bar, volatile LAS unsigned* st, int tid) {
    asm volatile("s_waitcnt vmcnt(0)" ::: "memory");
    __syncthreads();
    if (tid == 0) {
        const unsigned x = xb_xcc_id();
        __builtin_amdgcn_s_waitcnt(0);
        unsigned nloc = st[0], nx = st[1];
        if (nloc == 0u) { xcd_barrier_complete(bar, x, nloc, nx); st[0] = nloc; st[1] = nx; }
        const unsigned old = xb_add(&bar[XB_XSUB(x)], 1u);
        const unsigned gen = old / nloc;
        if (old + 1u == (gen + 1u) * nloc) {
            __builtin_amdgcn_fence(__ATOMIC_RELEASE, "agent");
            asm volatile("s_waitcnt vmcnt(0)" ::: "memory");
            const unsigned og = xb_add(&bar[XB_TOP], 1u);
            const unsigned tg = og / nx;
            if (og + 1u == (tg + 1u) * nx) xb_add(&bar[XB_TOPGEN], 1u);
            else XB_SPIN(xb_ld(&bar[XB_TOPGEN]) == tg, bar);
            __builtin_amdgcn_fence(__ATOMIC_ACQUIRE, "agent");
            xb_add(&bar[XB_XGEN(x)], 1u);
            asm volatile("s_waitcnt vmcnt(0)" ::: "memory");
        } else {
            XB_SPIN(xb_ld(&bar[XB_XGEN(x)]) == gen, bar);
            __builtin_amdgcn_fence(__ATOMIC_ACQUIRE, "agent");
            asm volatile("s_waitcnt vmcnt(0)" ::: "memory");
        }
    }
    __syncthreads();
}

constexpr int LDS_BYTES = 147456 + 256;
__global__ void __launch_bounds__(512, 2) mega(Ctx carg) {
    extern __shared__ __attribute__((aligned(16))) unsigned char lds_raw[];
    float* lds = (float*)lds_raw;
    const int wv0 = __builtin_amdgcn_readfirstlane((int)threadIdx.x >> 6);
#define WSP(T, off) ((T*)(c.ws + (off)))
    {
        volatile LAS unsigned* st = (volatile LAS unsigned*)((LAS unsigned char*)lds_raw + XB_LDS_OFF);
        if (threadIdx.x < 4) st[threadIdx.x] = 0u;
        __syncthreads();
        if (threadIdx.x == 0) { const Ctx& c = ctx(); (void)xb_add((unsigned*)c.ws + XB_BASE + XB_XCNT(xb_xcc_id()), 1u); }
    }
#define GSYNC() do { const Ctx& c_ = ctx(); const Blk B_ = mkblk(wv0); xcd_barrier((unsigned*)c_.ws + XB_BASE, (volatile LAS unsigned*)((LAS unsigned char*)lds_raw + XB_LDS_OFF), B_.tid); } while (0)

    { const Ctx& c = ctx(); const Blk B = mkblk(wv0); ph_mod(c, B, lds); ph_dftm2(c, B, lds); }
    { const Ctx& c = ctx(); const Blk B = mkblk(wv0); ph_wprep_small(c, B, lds); ph_wprep_fourier(c, B, lds); }
    { const Ctx& c = ctx(); const Blk B = mkblk(wv0); wait_mod(c, B); }
    { const Ctx& c = ctx(); const Blk B = mkblk(wv0); ph_router_const(c, B); ph_u(c, B); }
    GSYNC();
    { const Ctx& c = ctx(); const Blk B = mkblk(wv0); ph_gemm1(c, B, lds_raw); }
    GSYNC();
    { const Ctx& c = ctx(); const Blk B = mkblk(wv0); ph_dft_edge(c, B); ph_gdn_prep(c, B, lds_raw, 0); }
    GSYNC();
    { const Ctx& c = ctx(); const Blk B = mkblk(wv0); ph_gdn_scan(c, B, lds_raw, 0); if (B.bid >= 128) { ph_gdn_prep(c, B, lds_raw, 1); __syncthreads(); } ph_dft2(c, B, lds_raw, 128); if (B.bid >= 128) wprep_gate_queue(c, B, lds_raw); }
    GSYNC();
    { const Ctx& c = ctx(); const Blk B = mkblk(wv0); ph_dft_combine(c, B); ph_mergeprep2(c, B); }
    GSYNC();
    { const Ctx& c = ctx(); const Blk B = mkblk(wv0); ph_merge_ab(c, B, lds_raw); }
    GSYNC();
    { const Ctx& c = ctx(); const Blk B = mkblk(wv0); ph_merge_c(c, B, lds_raw); }
    GSYNC();
    { const Ctx& c = ctx(); const Blk B = mkblk(wv0); ph_router_fast(c, B, lds_raw); }
    { const Ctx& c = ctx(); const Blk B = mkblk(wv0); ph_wprep_moe(c, B, lds); }
    GSYNC();
    { const Ctx& c = ctx(); const Blk B = mkblk(wv0); ph_moe_gu(c, B, lds_raw); wprep_down_queue(c, B, lds_raw); }
    GSYNC();
    { const Ctx& c = ctx(); const Blk B = mkblk(wv0); ph_moe_down(c, B, lds_raw); }
    GSYNC();
    { const Ctx& c = ctx(); const Blk B = mkblk(wv0); ph_final(c, B, lds); }
}

extern "C" void kernel_launch(void* const* d_in, const int* in_sizes, int n_in, void* d_out, int out_size, void* d_ws, size_t ws_size, hipStream_t stream) {
    static int grid = 0;
    if (grid == 0) {
        if (n_in != 25 || ws_size < (size_t)512 * MiB || out_size != NT * D) { fprintf(stderr, "kernel_launch: unexpected sizes n_in %d ws %zu (need %zu) out %d\n", n_in, ws_size, (size_t)WS_NEED, out_size); grid = -1; return; }
        int dev = 0, cus = 0, per_cu = 0;
        if (hipGetDevice(&dev) != hipSuccess || hipDeviceGetAttribute(&cus, hipDeviceAttributeMultiprocessorCount, dev) != hipSuccess) { grid = -1; return; }
        if (hipFuncSetAttribute((const void*)mega, hipFuncAttributeMaxDynamicSharedMemorySize, LDS_BYTES) != hipSuccess) { fprintf(stderr, "kernel_launch: hipFuncSetAttribute failed\n"); grid = -1; return; }
        if (hipOccupancyMaxActiveBlocksPerMultiprocessor(&per_cu, (const void*)mega, 512, LDS_BYTES) != hipSuccess || per_cu < 1) { fprintf(stderr, "kernel_launch: occupancy query failed (%d)\n", per_cu); (void)hipGetLastError(); per_cu = 1; }
        grid = cus * 1;
        fprintf(stderr, "kernel_launch: cus %d per_cu %d grid %d ws %zu\n", cus, per_cu, grid, ws_size);
    }
    if (grid < 0) return;
    (void)hipMemsetAsync((char*)d_ws + WS_CTL, 0, 1 * MiB, stream);
    Ctx c{};
    const float** p = (const float**)&c;
    for (int i = 0; i < 25; ++i) p[i] = (const float*)d_in[i];
    c.out = (float*)d_out; c.ws = (char*)d_ws;
    void* args[] = {&c};
    hipError_t e = hipLaunchCooperativeKernel((const void*)mega, dim3(grid), dim3(512), args, LDS_BYTES, stream);
    if (e != hipSuccess) fprintf(stderr, "kernel_launch: cooperative launch failed: %s (grid %d)\n", hipGetErrorString(e), grid);
}
```

```cpp
#include <hip/hip_runtime.h>
#include <hip/hip_cooperative_groups.h>
#include <cstdio>
#include <cstdint>

typedef unsigned short u16;

constexpr int D = 1024, NB = 4, L = 4096, NT = NB * L, CT = 256, NC = NB * CT, MR = NT + NC;
constexpr int IN_COLS = 5664;
constexpr int NE = 32, CAP = 16384, SLOTS = 73728;
constexpr float EPS = 1e-6f;

constexpr size_t MiB = 1u << 20;
constexpr size_t WS_CTL = 0;
constexpr size_t WS_MOD = 1 * MiB;
constexpr size_t WS_TOPE = 2 * MiB;
constexpr size_t WS_TOPP = 3 * MiB;
constexpr size_t WS_TOKE = 4 * MiB;
constexpr size_t WS_WTE = 6 * MiB;
constexpr size_t WS_H2 = 392 * MiB;
constexpr size_t WS_B = 40 * MiB;
constexpr size_t WS_U = WS_B;
constexpr size_t WS_OB = WS_U;
constexpr size_t WS_QKV = WS_U + 34 * MiB;
constexpr size_t WS_T1 = WS_QKV;
constexpr size_t WS_BA = WS_QKV + 68 * MiB;
constexpr size_t WS_SZ = WS_BA + 3 * MiB;
constexpr size_t WS_GA = WS_SZ + 32 * MiB;
constexpr size_t WS_GB = WS_GA + 32 * MiB;
constexpr size_t WS_FB = WS_GB + 32 * MiB;
constexpr size_t WS_FT2 = WS_FB + 16 * MiB;
constexpr size_t WS_DFTM = WS_FT2 + 32 * MiB;
constexpr size_t WS_O = WS_DFTM;
constexpr size_t WS_FM = WS_DFTM + 64 * MiB;
constexpr size_t WS_QKVN = WS_FM + 16 * MiB;
constexpr size_t WS_M1 = WS_QKVN;
constexpr size_t WS_END_B = WS_QKVN + 68 * MiB;
constexpr size_t WS_ACT = WS_B;
constexpr size_t WS_Y = WS_B + 144 * MiB;
constexpr size_t WS_NEED = (WS_END_B > WS_Y + 144 * MiB) ? WS_END_B : (WS_Y + 144 * MiB);

__device__ __forceinline__ float bf2f(u16 v) { return __uint_as_float(((unsigned)v) << 16); }
__device__ __forceinline__ u16 f2bf(float f) { unsigned u = __float_as_uint(f); u += 0x7fffu + ((u >> 16) & 1u); return (u16)(u >> 16); }
__device__ __forceinline__ float sigmoidf_(float v) { return 1.f / (1.f + expf(-v)); }
__device__ __forceinline__ float siluf_(float v) { return v / (1.f + expf(-v)); }
__device__ __forceinline__ float softplusf_(float v) { return v > 20.f ? v : log1pf(expf(v)); }
__device__ __forceinline__ float wave_sum(float v) {
#pragma unroll
    for (int o = 1; o < 64; o <<= 1) v += __shfl_xor(v, o);
    return v;
}

namespace cg = cooperative_groups;
#define DI __device__ __forceinline__
constexpr size_t WS_FT2N = 458 * MiB;
constexpr size_t FE_OUT_OFF = 48 * MiB;
constexpr size_t FM_OUT_OFF = 32 * MiB;
constexpr size_t WS_NYQ = 506 * MiB;
constexpr size_t WS_IMGH = 24 * MiB;
constexpr size_t WS_O2 = 74 * MiB;
constexpr size_t WS_IMGHD = 241 * MiB;
constexpr int IMGH_STRIDE = 35840, IMGHD_STRIDE = 44032;
constexpr int IH_Q = 0, IH_KT = 17408;
constexpr int ID_W = 0, ID_QK = 17408, ID_G = 26624, ID_UT = 27648;
static_assert(WS_IMGH + (size_t)1088 * IMGH_STRIDE <= 62 * MiB && WS_IMGHD + (size_t)4352 * IMGHD_STRIDE <= 424 * MiB, "gdn images");

struct Ctx {
    const float *x, *c, *ctx, *c_ctx, *w_mod, *b_mod, *norm1_g, *norm2_g, *w_in, *conv_w, *a_log, *dt_bias, *gdn_norm_g, *w_fo, *w_go, *w_mo,
                *w_router, *b_router, *w_gate, *b_gate, *w_up, *b_up, *w_down, *b_down, *final_g;
    float* out; char* ws;
};
struct Blk { int G, bid, tid, wave, lane; };
DI Blk mkblk(int wv) { int g = gridDim.x, bi = blockIdx.x; asm volatile("" : "+s"(wv), "+s"(g), "+s"(bi)); Blk B; B.G = g; B.bid = bi; B.wave = wv;
    int ln; asm volatile("v_mbcnt_lo_u32_b32 %0, -1, 0\n\tv_mbcnt_hi_u32_b32 %0, -1, %0" : "=v"(ln)); B.lane = ln; B.tid = wv * 64 + ln; return B; }
DI const Ctx& ctx() { const __attribute__((address_space(4))) char* p = (const __attribute__((address_space(4))) char*)__builtin_amdgcn_kernarg_segment_ptr(); asm volatile("" : "+s"(p)); return *(const Ctx*)(const char*)p; }

constexpr int MOD_FLAG = 2304;
DI void ph_mod(const Ctx& c, const Blk& B, float* lds) {
    float* s = lds;
    float* part = lds + 5 * 1024;
    float* MOD = (float*)(c.ws + WS_MOD);
    for (int i = B.tid; i < 5 * 1024; i += 512) { const int r = i >> 10, k = i & 1023; const float v = r < 4 ? c.c[r * 1024 + k] : c.c_ctx[k]; s[i] = siluf_(v); }
    __syncthreads();
    for (int item = B.bid; item < 96; item += B.G) {
        const int n = item * 64 + B.lane;
        float a0 = 0.f, a1 = 0.f, a2 = 0.f, a3 = 0.f, a4 = 0.f;
        const int k0 = B.wave * 128;
#pragma unroll
        for (int k = k0; k < k0 + 128; ++k) { const float w = c.w_mod[(size_t)k * 6144 + n]; a0 += s[k] * w; a1 += s[1024 + k] * w; a2 += s[2048 + k] * w; a3 += s[3072 + k] * w; a4 += s[4096 + k] * w; }
        float* p = part + B.wave * 320 + B.lane;
        p[0] = a0; p[64] = a1; p[128] = a2; p[192] = a3; p[256] = a4;
        __syncthreads();
        if (B.tid < 320) { const int r = B.tid >> 6, l = B.tid & 63; float t = 0.f;
#pragma unroll
            for (int w = 0; w < 8; ++w) t += part[w * 320 + r * 64 + l];
            MOD[r * 6144 + item * 64 + l] = t + c.b_mod[item * 64 + l]; }
        asm volatile("s_waitcnt vmcnt(0)" ::: "memory");
        __syncthreads();
        if (B.tid == 0) { __builtin_amdgcn_fence(__ATOMIC_RELEASE, "agent"); __hip_atomic_fetch_add((unsigned*)c.ws + MOD_FLAG, 1u, __ATOMIC_RELEASE, __HIP_MEMORY_SCOPE_AGENT); }
    }
}
DI void wait_mod(const Ctx& c, const Blk& B) {
    if (B.tid == 0) {
        while (__hip_atomic_load((unsigned*)c.ws + MOD_FLAG, __ATOMIC_RELAXED, __HIP_MEMORY_SCOPE_AGENT) < 96u) __builtin_amdgcn_s_sleep(2);
        __builtin_amdgcn_fence(__ATOMIC_ACQUIRE, "agent");
    }
    __syncthreads();
}
DI void u_row(const Ctx& c, const float* MOD, const float* src, int mr, int lane, float (&y)[16]) {
    float4 v[4]; float ss = 0.f;
#pragma unroll
    for (int j = 0; j < 4; ++j) { v[j] = ((const float4*)src)[lane + 64 * j]; ss += v[j].x * v[j].x + v[j].y * v[j].y + v[j].z * v[j].z + v[j].w * v[j].w; }
    ss = wave_sum(ss);
    const float rstd = rsqrtf(ss * (1.f / D) + EPS);
    const float* sh = MOD + mr * 6144; const float* sc = sh + 1024;
#pragma unroll
    for (int j = 0; j < 4; ++j) {
        const int k = (lane + 64 * j) * 4;
        const float4 g = *(const float4*)(c.norm1_g + k), s4 = *(const float4*)(sc + k), h4 = *(const float4*)(sh + k);
        y[4 * j] = v[j].x * rstd * g.x * (1.f + s4.x) + h4.x; y[4 * j + 1] = v[j].y * rstd * g.y * (1.f + s4.y) + h4.y;
        y[4 * j + 2] = v[j].z * rstd * g.z * (1.f + s4.z) + h4.z; y[4 * j + 3] = v[j].w * rstd * g.w * (1.f + s4.w) + h4.w;
    }
}
DI void u_store(u16* dst, int lane, const float (&y)[16]) {
#pragma unroll
    for (int j = 0; j < 4; ++j) { ushort4 o4; o4.x = f2bf(y[4 * j]); o4.y = f2bf(y[4 * j + 1]); o4.z = f2bf(y[4 * j + 2]); o4.w = f2bf(y[4 * j + 3]); *(ushort4*)(dst + (lane + 64 * j) * 4) = o4; }
}
DI void u_task(const Ctx& c, const float* MOD, u16* U, u16* UE, u16* UO, int task, int lane) {
    float ya[16];
    if (task >= 4 * 2049) { const int row = NT + task - 4 * 2049; u_row(c, MOD, c.ctx + (size_t)(row - NT) * D, 4, lane, ya); u_store(U + (size_t)row * D, lane, ya); return; }
    const int b = task / 2049, l = task % 2049, rowA = b * L + l;
    u_row(c, MOD, c.x + (size_t)rowA * D, b, lane, ya); u_store(U + (size_t)rowA * D, lane, ya);
    if (l == 2048) { u_store((u16*)(c.ws + WS_NYQ + 16384) + (size_t)b * D, lane, ya); return; }
    float e[16], o[16];
    if (l >= 1) {
        float yb[16]; const int rowB = b * L + (L - l);
        u_row(c, MOD, c.x + (size_t)rowB * D, b, lane, yb); u_store(U + (size_t)rowB * D, lane, yb);
#pragma unroll
        for (int i = 0; i < 16; ++i) { e[i] = ya[i] + yb[i]; o[i] = ya[i] - yb[i]; }
    } else {
#pragma unroll
        for (int i = 0; i < 16; ++i) { e[i] = ya[i]; o[i] = 0.f; }
    }
    u_store(UE + (size_t)(b * 2048 + l) * D, lane, e); u_store(UO + (size_t)(b * 2048 + l) * D, lane, o);
}
DI void ph_u(const Ctx& c, const Blk& B, float* lds) {
    const float* MOD = (const float*)(c.ws + WS_MOD); u16* U = (u16*)(c.ws + WS_U); u16* UE = (u16*)(c.ws + WS_FT2N); u16* UO = UE + (size_t)8192 * 1024;
    int* slot = (int*)lds;
    unsigned* ctr = (unsigned*)c.ws + 2368;
    constexpr int NTASK = 4 * 2049 + NC, NTICK = (NTASK + 7) / 8;
    __syncthreads();
    if (B.tid == 0) *slot = (int)__hip_atomic_fetch_add(ctr, 1u, __ATOMIC_RELAXED, __HIP_MEMORY_SCOPE_AGENT);
    for (;;) {
        __syncthreads();
        const int tk = *slot;
        __syncthreads();
        if (tk >= NTICK) break;
        int nextv = 0;
        if (B.tid == 0) nextv = (int)__hip_atomic_fetch_add(ctr, 1u, __ATOMIC_RELAXED, __HIP_MEMORY_SCOPE_AGENT);
        const int task = tk * 8 + B.wave;
        if (task < NTASK) u_task(c, MOD, U, UE, UO, task, B.lane);
        if (B.tid == 0) *slot = nextv;
    }
}
DI void moe_tables(const Ctx& c, const Blk& B, int* tab) {
    const int* cnt = (const int*)(c.ws + WS_CTL);
    __syncthreads();
    if (B.tid == 0) { int ts = 0, sb = 0; for (int e = 0; e < 32; ++e) { const int n = cnt[64 * e]; tab[e] = ts; tab[40 + e] = sb; tab[80 + e] = n; ts += ((n + 63) / 64) * 16; sb += (n + 255) & ~255; } tab[32] = ts; tab[72] = sb; }
    __syncthreads();
}
DI void ph_final(const Ctx& c, const Blk& B, float* lds) {
    int* tab = (int*)lds;
    moe_tables(c, B, tab);
    const u16* Y = (const u16*)(c.ws + WS_Y); const int* TOPE = (const int*)(c.ws + WS_TOPE); const int* TOPP = (const int*)(c.ws + WS_TOPP); const float* MOD = (const float*)(c.ws + WS_MOD);
    float* out = c.out;
    for (int row = B.bid * 8 + B.wave; row < NT; row += B.G * 8) {
        const int b = row / L;
        int yrow[4];
#pragma unroll
        for (int j = 0; j < 4; ++j) yrow[j] = tab[40 + TOPE[row * 4 + j]] + TOPP[row * 4 + j];
        float x2[16]; float ss = 0.f;
#pragma unroll
        for (int q = 0; q < 4; ++q) {
            const int k = (B.lane + 64 * q) * 4;
            const float4 x1 = *(const float4*)(out + (size_t)row * D + k);
            float a[4] = {0.f, 0.f, 0.f, 0.f};
#pragma unroll
            for (int j = 0; j < 4; ++j) { const ushort4 y = *(const ushort4*)(Y + (size_t)yrow[j] * D + k); a[0] += bf2f(y.x); a[1] += bf2f(y.y); a[2] += bf2f(y.z); a[3] += bf2f(y.w); }
            const float4 g2 = *(const float4*)(MOD + b * 6144 + 5120 + k);
            x2[q * 4 + 0] = x1.x + g2.x * a[0]; x2[q * 4 + 1] = x1.y + g2.y * a[1]; x2[q * 4 + 2] = x1.z + g2.z * a[2]; x2[q * 4 + 3] = x1.w + g2.w * a[3];
#pragma unroll
            for (int i = 0; i < 4; ++i) ss += x2[q * 4 + i] * x2[q * 4 + i];
        }
        ss = wave_sum(ss);
        const float rstd = rsqrtf(ss * (1.f / D) + EPS);
#pragma unroll
        for (int q = 0; q < 4; ++q) {
            const int k = (B.lane + 64 * q) * 4;
            const float4 g = *(const float4*)(c.final_g + k);
            float4 o; o.x = x2[q * 4] * rstd * g.x; o.y = x2[q * 4 + 1] * rstd * g.y; o.z = x2[q * 4 + 2] * rstd * g.z; o.w = x2[q * 4 + 3] * rstd * g.w;
            *(float4*)(out + (size_t)row * D + k) = o;
        }
    }
}

namespace pg {
#define LAS __attribute__((address_space(3)))
typedef short bf16x8 __attribute__((ext_vector_type(8)));
typedef float f32x4 __attribute__((ext_vector_type(4)));
typedef unsigned u32x4 __attribute__((ext_vector_type(4)));
typedef unsigned u32x2 __attribute__((ext_vector_type(2)));
constexpr int HTB = 128 * 64 * 2;
DI int lds_byte(int r, int c) { const int st = (r >> 4) * 2 + (c >> 5), rr = r & 15, cc = c & 31, ob = rr * 64 + cc * 2; return st * 1024 + (ob ^ (((ob >> 9) & 1) << 5)); }
DI void stage_rc(int b, int& R, int& C) { const int st = b / 1024, sb = b % 1024, swz = sb ^ (((sb >> 9) & 1) << 5); R = (st >> 1) * 16 + swz / 64; C = (st & 1) * 32 + (swz % 64) / 2; }
DI int perm32(int rho) { const int n = rho >> 4, i = rho & 15; return 8 * (i >> 2) + 4 * n + (i & 3); }
typedef float f32x2_ __attribute__((ext_vector_type(2)));
typedef __bf16 bf16x2_ __attribute__((ext_vector_type(2)));
DI unsigned cvt_pk_bf16(float lo, float hi) { const f32x2_ v = {lo, hi}; return __builtin_bit_cast(unsigned, __builtin_convertvector(v, bf16x2_)); }

struct Unit {
    const char *a0, *a1;
    const char *b0, *b1;
    unsigned v00, v01, v10, v11;
    int nt;
    int kind, pm, pn, ex;
};
DI void lane_rc(int tid, int i, int& R, int& C) { stage_rc(tid * 16 + i * 8192, R, C); }

template <bool PERM, bool GATHER, class Sched, class Epi>
DI void gemm_phase(LAS unsigned char* lds, int tid_in, int lda_elems, int ldb_elems, const Sched& S, const Epi& E) {
    const int tid = tid_in, wid = __builtin_amdgcn_readfirstlane(tid >> 6), lane = tid & 63, wr = wid >> 2, wc = wid & 3, fr = lane & 15, fq = lane >> 4;
    unsigned voffB0, voffB1, voffA0, voffA1;
    { int R, C; lane_rc(tid, 0, R, C); const int Rb = PERM ? ((R & ~31) + perm32(R & 31)) : R; voffB0 = (unsigned)(Rb * ldb_elems + C) * 2u; voffA0 = (unsigned)(R * lda_elems + C) * 2u; }
    { int R, C; lane_rc(tid, 1, R, C); const int Rb = PERM ? ((R & ~31) + perm32(R & 31)) : R; voffB1 = (unsigned)(Rb * ldb_elems + C) * 2u; voffA1 = (unsigned)(R * lda_elems + C) * 2u; }
#define VA0(u, h) (GATHER ? ((h) ? (u).v10 : (u).v00) : voffA0)
#define VA1(u, h) (GATHER ? ((h) ? (u).v11 : (u).v01) : voffA1)
    const unsigned ldsw = (unsigned)wid * 1024u;
    const int aoff = lds_byte(wr * 64 + fr, fq * 8), boff = lds_byte(wc * 32 + fr, fq * 8);
#define PG_SA(b, h) (((b) * 2 + (h)) * HTB)
#define PG_SB(b, h) ((4 + (b) * 2 + (h)) * HTB)
#define PG_STAGE2(bufoff, gbase, o0, o1) do { \
        __builtin_amdgcn_global_load_lds((const unsigned*)((const char*)(gbase) + (o0)), (LAS unsigned*)(lds + (bufoff) + ldsw), 16, 0, 0); \
        __builtin_amdgcn_global_load_lds((const unsigned*)((const char*)(gbase) + (o1)), (LAS unsigned*)(lds + (bufoff) + ldsw + 8192), 16, 0, 0); } while (0)
#define PG_STAGEB(bufoff, gbase) PG_STAGE2(bufoff, gbase, voffB0, voffB1)
#define PG_LDA(dst, b, h) do { _Pragma("unroll") for (int m = 0; m < 4; ++m) _Pragma("unroll") for (int k = 0; k < 2; ++k) dst[m][k] = *(const LAS bf16x8*)(lds + PG_SA(b, h) + aoff + m * 2048 + k * 1024); } while (0)
#define PG_LDB(dst, b, h) do { _Pragma("unroll") for (int n = 0; n < 2; ++n) _Pragma("unroll") for (int k = 0; k < 2; ++k) dst[n][k] = *(const LAS bf16x8*)(lds + PG_SB(b, h) + boff + n * 2048 + k * 1024); } while (0)
#define PG_MMA(ai, bj, At, Bt) do { __builtin_amdgcn_s_setprio(1); _Pragma("unroll") for (int m = 0; m < 4; ++m) _Pragma("unroll") for (int n = 0; n < 2; ++n) _Pragma("unroll") for (int k = 0; k < 2; ++k) \
        acc[ai][bj][m][n] = __builtin_amdgcn_mfma_f32_16x16x32_bf16(Bt[n][k], At[m][k], acc[ai][bj][m][n], 0, 0, 0); __builtin_amdgcn_s_setprio(0); } while (0)
#define PG_WAIT_V(n) asm volatile("s_waitcnt vmcnt(" #n ")" ::: "memory")
#define PG_WAIT_L(n) asm volatile("s_waitcnt lgkmcnt(" #n ")" ::: "memory")
#define PG_BAR __builtin_amdgcn_s_barrier()
#define PG_SCHED __builtin_amdgcn_sched_barrier(0)
    Unit cur, nxt; int ui = 0;
    if (!S.next(0, cur)) return;
    f32x4 acc[2][2][4][2];
#pragma unroll
    for (int a = 0; a < 2; ++a)
#pragma unroll
        for (int b = 0; b < 2; ++b)
#pragma unroll
            for (int m = 0; m < 4; ++m)
#pragma unroll
                for (int n = 0; n < 2; ++n) acc[a][b][m][n] = (f32x4){0.f, 0.f, 0.f, 0.f};
    bf16x8 At[4][2], B0[2][2], B1[2][2];
    PG_STAGEB(PG_SB(0, 0), cur.b0); PG_STAGEB(PG_SB(0, 1), cur.b1); PG_STAGE2(PG_SA(0, 0), cur.a0, VA0(cur, 0), VA1(cur, 0)); PG_STAGE2(PG_SA(0, 1), cur.a1, VA0(cur, 1), VA1(cur, 1));
    if (wr == 1) PG_BAR;
    PG_WAIT_V(2); PG_BAR;
    PG_STAGEB(PG_SB(1, 0), cur.b0 + 128); PG_STAGE2(PG_SA(1, 0), cur.a0 + 128, VA0(cur, 0), VA1(cur, 0)); PG_STAGEB(PG_SB(1, 1), cur.b1 + 128);
    PG_WAIT_V(6); PG_BAR;
    for (;;) {
        const bool has_next = S.next(ui + 1, nxt);
        if (!has_next) nxt = cur;
        const int nt = cur.nt;
        for (int t = 0; t < nt; t += 2) {
            const bool last = (t == nt - 2);
            const size_t o1 = (size_t)(t + 1) * 128, o2 = last ? 0 : (size_t)(t + 2) * 128;
            const char* a20 = (last ? nxt.a0 : cur.a0) + o2; const char* a21 = (last ? nxt.a1 : cur.a1) + o2;
            const char* b20 = (last ? nxt.b0 : cur.b0) + o2; const char* b21 = (last ? nxt.b1 : cur.b1) + o2;
            unsigned w00, w01, w10, w11;
            if (GATHER) { w00 = last ? nxt.v00 : cur.v00; w01 = last ? nxt.v01 : cur.v01; w10 = last ? nxt.v10 : cur.v10; w11 = last ? nxt.v11 : cur.v11; }
            else { w00 = voffA0; w01 = voffA1; w10 = voffA0; w11 = voffA1; }
            PG_LDB(B0, 0, 0); PG_LDB(B1, 0, 1); PG_SCHED; PG_LDA(At, 0, 0); PG_STAGE2(PG_SA(1, 1), cur.a1 + o1, VA0(cur, 1), VA1(cur, 1));
            PG_WAIT_V(8); PG_WAIT_L(0); PG_BAR; PG_MMA(0, 0, At, B0); PG_MMA(0, 1, At, B1); PG_BAR; PG_SCHED;
            PG_LDA(At, 0, 1); PG_STAGEB(PG_SB(0, 0), b20); PG_STAGEB(PG_SB(0, 1), b21); PG_STAGE2(PG_SA(0, 0), a20, w00, w01);
            PG_WAIT_V(8); PG_WAIT_L(0); PG_BAR; PG_MMA(1, 0, At, B0); PG_MMA(1, 1, At, B1); PG_BAR; PG_SCHED;
            PG_LDB(B0, 1, 0); PG_LDB(B1, 1, 1); PG_SCHED; PG_LDA(At, 1, 0); PG_STAGE2(PG_SA(0, 1), a21, w10, w11);
            PG_WAIT_V(8); PG_WAIT_L(0); PG_BAR; PG_MMA(0, 0, At, B0); PG_MMA(0, 1, At, B1); PG_BAR; PG_SCHED;
            PG_LDA(At, 1, 1); PG_STAGEB(PG_SB(1, 0), b20 + 128); PG_STAGEB(PG_SB(1, 1), b21 + 128); PG_STAGE2(PG_SA(1, 0), a20 + 128, w00, w01);
            PG_WAIT_V(8); PG_WAIT_L(0); PG_BAR; PG_MMA(1, 0, At, B0); PG_MMA(1, 1, At, B1); PG_BAR; PG_SCHED;
        }
        if (wr == 0) PG_BAR;
        E(acc, cur, wr, wc, fr, fq);
        if (!has_next) break;
#pragma unroll
        for (int a = 0; a < 2; ++a)
#pragma unroll
            for (int b = 0; b < 2; ++b)
#pragma unroll
                for (int m = 0; m < 4; ++m)
#pragma unroll
                    for (int n = 0; n < 2; ++n) acc[a][b][m][n] = (f32x4){0.f, 0.f, 0.f, 0.f};
        cur = nxt; ++ui;
        if (wr == 1) PG_BAR;
    }
    PG_WAIT_V(0);
    PG_BAR;
#undef VA0
#undef VA1
#undef PG_SA
#undef PG_SB
#undef PG_STAGE2
#undef PG_STAGEB
#undef PG_LDA
#undef PG_LDB
#undef PG_MMA
#undef PG_WAIT_V
#undef PG_WAIT_L
#undef PG_BAR
#undef PG_SCHED
}
}

constexpr size_t WS_SSP = 242 * MiB;
constexpr size_t WS_WINT = 440 * MiB;
constexpr size_t WS_WFT = WS_WINT + 11 * MiB;
constexpr size_t WS_WFOT = WS_WFT + 2 * MiB;
constexpr size_t WS_WGOT = WS_WFOT + 1 * MiB;
constexpr size_t WS_WMOT = WS_WGOT + 2 * MiB;
constexpr size_t WS_WGT = WS_B + 144 * MiB;
constexpr size_t WS_WUT = WS_WGT + 64 * MiB;
constexpr size_t WS_WDT = WS_WUT + 64 * MiB + 16 * MiB;
static_assert(WS_WMOT + 2 * MiB <= 512 * MiB && WS_WDT + 64 * MiB <= WS_WINT, "ws map");

DI unsigned pk2(float lo, float hi) { return (unsigned)f2bf(lo) | ((unsigned)f2bf(hi) << 16); }
DI void transpose_item(const float* src, int ldw, u16* WT, int K, int k0, int dst_row, float* scr, int lane, bool zero) {
    if (!zero) {
        pg::f32x4 v[8];
#pragma unroll
        for (int t = 0; t < 8; ++t) v[t] = *(const pg::f32x4*)(src + (size_t)(k0 + 8 * t + (lane >> 3)) * ldw + (lane & 7) * 4);
#pragma unroll
        for (int t = 0; t < 8; ++t) { float* d = scr + (8 * t + (lane >> 3)) * 33 + (lane & 7) * 4; d[0] = v[t][0]; d[1] = v[t][1]; d[2] = v[t][2]; d[3] = v[t][3]; }
    }
    asm volatile("s_waitcnt lgkmcnt(0)" ::: "memory");
    const int cc = lane & 7;
#pragma unroll
    for (int j = 0; j < 4; ++j) { const int n = (lane >> 3) + 8 * j; const float* s = scr + (8 * cc) * 33 + n;
        uint4 o;
        if (zero) o = make_uint4(0u, 0u, 0u, 0u);
        else { o.x = pk2(s[0 * 33], s[1 * 33]); o.y = pk2(s[2 * 33], s[3 * 33]); o.z = pk2(s[4 * 33], s[5 * 33]); o.w = pk2(s[6 * 33], s[7 * 33]); }
        *(uint4*)(WT + (size_t)(dst_row + n) * K + k0 + 8 * cc) = o; }
    asm volatile("s_waitcnt lgkmcnt(0)" ::: "memory");
}
DI void wprep_small_item(const Ctx& c, int r, float* scr, int lane) {
    u16* WINT = (u16*)(c.ws + WS_WINT); u16* WFOT = (u16*)(c.ws + WS_WFOT); u16* WGOT = (u16*)(c.ws + WS_WGOT); u16* WMOT = (u16*)(c.ws + WS_WMOT);
    constexpr int I_IN = 168 * 16, I_FO = 32 * 8, I_GO = 32 * 16;
    if (r < I_IN) { const int nb = r >> 4, kb = r & 15, n0 = nb * 32;
        int sc; bool zero = false;
        if (n0 < 2048) sc = n0; else if (n0 < 3072) sc = 2080 + (n0 - 2048); else if (n0 < 4096) sc = 3616 + (n0 - 3072); else if (n0 < 5120) sc = 4640 + (n0 - 4096); else if (n0 < 5152) sc = 2048; else { sc = 0; zero = true; }
        transpose_item(c.w_in + sc, IN_COLS, WINT, 1024, kb * 64, n0, scr, lane, zero); return; }
    r -= I_IN;
    if (r < I_FO) { const int nb = r >> 3, kb = r & 7; transpose_item(c.w_fo + nb * 32, 1024, WFOT, 512, kb * 64, nb * 32, scr, lane, false); return; }
    r -= I_FO;
    if (r < I_GO) { const int nb = r >> 4, kb = r & 15; transpose_item(c.w_go + nb * 32, 1024, WGOT, 1024, kb * 64, nb * 32, scr, lane, false); return; }
    r -= I_GO;
    { const int nb = r >> 4, kb = r & 15; transpose_item(c.w_mo + nb * 32, 1024, WMOT, 1024, kb * 64, nb * 32, scr, lane, false); }
}
DI void ph_wprep_small(const Ctx& c, const Blk& B, float* lds) {
    float* scr = lds + B.wave * 2176;
    constexpr int I_ALL = 168 * 16 + 32 * 8 + 32 * 16 + 32 * 16;
    int* slot = (int*)(lds + 8 * 2176);
    unsigned* ctr = (unsigned*)c.ws + 2176;
    __syncthreads();
    if (B.tid == 0) *slot = (int)__hip_atomic_fetch_add(ctr, 1u, __ATOMIC_RELAXED, __HIP_MEMORY_SCOPE_AGENT);
    for (;;) {
        __syncthreads();
        const int tk = *slot;
        __syncthreads();
        if (tk * 8 >= I_ALL) break;
        int nextv = 0;
        if (B.tid == 0) nextv = (int)__hip_atomic_fetch_add(ctr, 1u, __ATOMIC_RELAXED, __HIP_MEMORY_SCOPE_AGENT);
        const int it = tk * 8 + B.wave;
        if (it < I_ALL) wprep_small_item(c, it, scr, B.lane);
        if (B.tid == 0) *slot = nextv;
    }
}
DI size_t early_off(int m) { return m < 14 ? ((size_t)424 * MiB + (size_t)m * 2 * MiB) : m < 38 ? ((size_t)458 * MiB + (size_t)(m - 14) * 2 * MiB) : m < 40 ? ((size_t)507 * MiB + (size_t)(m - 38) * 2 * MiB) : ((size_t)8 * MiB + (size_t)(m - 40) * 2 * MiB); }
DI size_t gate_off(int e) { return early_off(e); }
DI size_t up_off(int e) { return e < 16 ? early_off(32 + e) : (WS_WUT + (size_t)e * 2 * MiB); }
constexpr int N_EARLY = 48;
DI void transpose64(const float* W, u16* WT, float* scr, int lane) {
    pg::f32x4 v[16];
#pragma unroll
    for (int t = 0; t < 16; ++t) v[t] = __builtin_nontemporal_load((const pg::f32x4*)(W + (size_t)(4 * t + (lane >> 4)) * D + (lane & 15) * 4));
#pragma unroll
    for (int t = 0; t < 16; ++t) { float* d = scr + (4 * t + (lane >> 4)) * 65 + (lane & 15) * 4; d[0] = v[t][0]; d[1] = v[t][1]; d[2] = v[t][2]; d[3] = v[t][3]; }
    asm volatile("s_waitcnt lgkmcnt(0)" ::: "memory");
    const int cc = lane & 7;
#pragma unroll
    for (int j = 0; j < 8; ++j) { const int n = (lane >> 3) + 8 * j; const float* s = scr + (8 * cc) * 65 + n;
        pg::u32x4 o; o.x = pk2(s[0 * 65], s[1 * 65]); o.y = pk2(s[2 * 65], s[3 * 65]); o.z = pk2(s[4 * 65], s[5 * 65]); o.w = pk2(s[6 * 65], s[7 * 65]);
        __builtin_nontemporal_store(o, (pg::u32x4*)(WT + (size_t)n * D + 8 * cc)); }
    asm volatile("s_waitcnt lgkmcnt(0)" ::: "memory");
}
DI void wprep_gate_queue(const Ctx& c, const Blk& B, unsigned char* lds_raw) {
    float* scr = (float*)lds_raw + B.wave * 4160;
    LAS int* slot = (LAS int*)((LAS unsigned char*)lds_raw + 140000);
    unsigned* ctr = (unsigned*)c.ws + 2240;
    for (;;) {
        __syncthreads();
        if (B.tid == 0) *slot = (int)__hip_atomic_fetch_add(ctr, 1u, __ATOMIC_RELAXED, __HIP_MEMORY_SCOPE_AGENT);
        __syncthreads();
        const int bi = *slot;
        if (bi >= N_EARLY * 32) break;
        const int it = bi * 8 + B.wave, m = it >> 8, r = it & 255, nb = r >> 4, kb = r & 15;
        transpose64((m < 32 ? c.w_gate + (size_t)m * D * D : c.w_up + (size_t)(m - 32) * D * D) + (size_t)(kb * 64) * D + nb * 64, (u16*)(c.ws + early_off(m)) + (size_t)(nb * 64) * D + kb * 64, scr, B.lane);
    }
}
DI void ph_wprep_moe(const Ctx& c, const Blk& B, float* lds) {
    float* scr = lds + B.wave * 4160;
    const int lane = B.lane, nit = 2, it0 = B.bid * 16 + B.wave * 2;
    for (int j0 = 0; j0 < nit; ++j0) {
        const int it = it0 + j0;
        const int e = 16 + (it >> 8), r = it & 255, nb = r >> 4, kb = r & 15;
        transpose64(c.w_up + (size_t)e * D * D + (size_t)(kb * 64) * D + nb * 64, (u16*)(c.ws + up_off(e)) + (size_t)(nb * 64) * D + kb * 64, scr, lane);
    }
}
DI float cos_rev(int ix, float inv) { return __builtin_amdgcn_cosf((float)ix * inv); }
DI void ph_wprep_fourier(const Ctx& c, const Blk& B, float* lds) {
    u16* WFT = (u16*)(c.ws + WS_WFT);
    float* tile = lds;
    const int lane = B.lane, i16 = lane & 15, kq = lane >> 4, nt = B.wave & 3, mp = B.wave >> 2;
    for (int item = B.bid; item < 256; item += B.G) {
        const int g = item >> 6, k0 = ((item >> 2) & 15) * 64, mpart = item & 3;
        __syncthreads();
#pragma unroll
        for (int t = 0; t < 4; ++t) { const int ix = B.tid + 512 * t, r = ix >> 5, c4 = (ix & 31) * 4;
            const float* sp = c.w_in + (size_t)(k0 + r) * IN_COLS + 3104 + g * 128 + c4;
            *(pg::f32x4*)(tile + r * 132 + c4) = *(const pg::f32x4*)sp; }
        __syncthreads();
        const int m = mpart * 32 + (nt & 1) * 16 + i16, ph = (nt >> 1) ? 96 : 0;
        pg::f32x4 a0 = (pg::f32x4){0.f, 0.f, 0.f, 0.f}, a1 = a0;
        const float* ta = tile + (mp * 32 + i16) * 132 + kq;
#pragma unroll 8
        for (int s = 0; s < 32; ++s) {
            const float bv = cos_rev(((4 * s + kq) * m + ph) & 127, 1.f / 128.f);
            a0 = __builtin_amdgcn_mfma_f32_16x16x4f32(ta[4 * s], bv, a0, 0, 0, 0);
            a1 = __builtin_amdgcn_mfma_f32_16x16x4f32(ta[16 * 132 + 4 * s], bv, a1, 0, 0, 0);
        }
        u16* orow = WFT + (size_t)((nt >> 1) * 512 + g * 128 + m) * 1024 + k0 + mp * 32 + 4 * kq;
        *(uint2*)orow = make_uint2(pg::cvt_pk_bf16(a0[0], a0[1]), pg::cvt_pk_bf16(a0[2], a0[3])); *(uint2*)(orow + 16) = make_uint2(pg::cvt_pk_bf16(a1[0], a1[1]), pg::cvt_pk_bf16(a1[2], a1[3]));
    }
    __syncthreads();
}

struct SchedG1 {
    const char* U; const char* WINT; const char* WFT; const char* UEO; int G, c;
    DI bool next(int i, pg::Unit& u) const {
        const int Lx = i * G + c;
        if (Lx >= 1508) return false;
        const char *a, *b;
        if (Lx < 1344) {
            int wgid = Lx; { const int nwg = 1344, q = nwg / 8, r = nwg % 8, xcd = wgid % 8, off = wgid / 8; wgid = (xcd < r ? xcd * (q + 1) : r * (q + 1) + (xcd - r) * q) + off; }
            const int nig = 8 * 21, gid = wgid / nig, fm = gid * 8, gsz = (64 - fm) < 8 ? (64 - fm) : 8;
            u.pm = fm + ((wgid % nig) % gsz); u.pn = (wgid % nig) / gsz; u.kind = 0;
            a = U + (size_t)u.pm * 256 * 2048; b = WINT + (size_t)u.pn * 256 * 2048;
        } else if (Lx < 1380) {
            const int r = Lx - 1344, j = r % 9; u.pm = 64 + r / 9; u.pn = j < 8 ? j : 20; u.kind = 0;
            a = U + (size_t)u.pm * 256 * 2048; b = WINT + (size_t)u.pn * 256 * 2048;
        } else {
            const int r = Lx - 1380; u.pm = r >> 5; u.pn = r & 31; u.kind = 1;
            a = WFT + (size_t)u.pm * 256 * 2048; b = UEO + (size_t)(u.pm >> 1) * 8192 * 2048 + (size_t)u.pn * 256 * 2048;
        }
        u.a0 = a; u.a1 = a + 128 * 2048; u.b0 = b; u.b1 = b + 128 * 2048; u.v00 = u.v01 = u.v10 = u.v11 = 0u;
        u.nt = 16; u.ex = 0;
        return true;
    }
};
DI float fsilu(float v) { return v / (1.f + __expf(-v)); }
DI float fsigm(float v) { return 1.f / (1.f + __expf(-v)); }
struct EpiG1 {
    u16 *QKV, *SZ, *GA, *GB, *FT2; float* BA;
    DI void operator()(const pg::f32x4 (&acc)[2][2][4][2], const pg::Unit& u, int wr, int wc, int fr, int fq) const {
        const int c0 = wc * 32 + 8 * fq;
        if (u.kind == 0 && u.pn == 20) {
            if (wc == 0) {
#pragma unroll
                for (int ai = 0; ai < 2; ++ai)
#pragma unroll
                    for (int m = 0; m < 4; ++m) { const size_t row = (size_t)u.pm * 256 + ai * 128 + wr * 64 + m * 16 + fr;
                        *(pg::f32x4*)(BA + row * 32 + c0) = acc[ai][0][m][0]; *(pg::f32x4*)(BA + row * 32 + c0 + 4) = acc[ai][0][m][1]; }
            }
            return;
        }
        u16* base; size_t pitch; int mode;
        size_t rowbase;
        if (u.kind == 0) {
            rowbase = (size_t)u.pm * 256;
            if (u.pn < 8) { base = QKV + u.pn * 256; pitch = 2048; mode = 0; }
            else if (u.pn < 12) { base = SZ + (u.pn - 8) * 256; pitch = 1024; mode = 1; }
            else if (u.pn < 16) { base = GA + (u.pn - 12) * 256; pitch = 1024; mode = 2; }
            else { base = GB + (u.pn - 16) * 256; pitch = 1024; mode = 2; }
        } else {
            const int cs = u.pm >> 1, bb = u.pn >> 3;
            base = FT2 + ((size_t)bb * 512 + (u.pm & 1) * 256) * 4096 + cs * 2048 + (u.pn & 7) * 256; pitch = 4096; mode = 0; rowbase = 0;
        }
#pragma unroll
        for (int ai = 0; ai < 2; ++ai)
#pragma unroll
            for (int m = 0; m < 4; ++m) { u16* rowp = base + (rowbase + ai * 128 + wr * 64 + m * 16 + fr) * pitch + c0;
#pragma unroll
                for (int bj = 0; bj < 2; ++bj) { pg::f32x4 v0 = acc[ai][bj][m][0], v1 = acc[ai][bj][m][1];
                    if (mode == 1) {
#pragma unroll
                        for (int j = 0; j < 4; ++j) { v0[j] = fsilu(v0[j]); v1[j] = fsilu(v1[j]); } }
                    else if (mode == 2) {
#pragma unroll
                        for (int j = 0; j < 4; ++j) { v0[j] = fsigm(v0[j]); v1[j] = fsigm(v1[j]); } }
                    pg::u32x4 w; w.x = pg::cvt_pk_bf16(v0[0], v0[1]); w.y = pg::cvt_pk_bf16(v0[2], v0[3]); w.z = pg::cvt_pk_bf16(v1[0], v1[1]); w.w = pg::cvt_pk_bf16(v1[2], v1[3]);
                    if (mode != 0) __builtin_nontemporal_store(w, (pg::u32x4*)(rowp + bj * 128));
                    else *(pg::u32x4*)(rowp + bj * 128) = w; } }
    }
};
DI void ph_gemm1(const Ctx& c, const Blk& B, unsigned char* lds_raw) {
    SchedG1 S; S.U = c.ws + WS_U; S.WINT = c.ws + WS_WINT; S.WFT = c.ws + WS_WFT; S.UEO = c.ws + WS_FT2N; S.G = B.G; S.c = B.bid;
    EpiG1 E{(u16*)(c.ws + WS_QKV), (u16*)(c.ws + WS_SZ), (u16*)(c.ws + WS_GA), (u16*)(c.ws + WS_GB), (u16*)((char*)c.out + FE_OUT_OFF), (float*)(c.ws + WS_BA)};
    pg::gemm_phase<true, false>((LAS unsigned char*)lds_raw, B.tid, 1024, 1024, S, E);
}

struct SchedTile {
    const char* A; const char* Bt; int lda, G, c;
    DI bool next(int i, pg::Unit& u) const {
        const int Lx = i * G + c; if (Lx >= 256) return false;
        int wgid = Lx; { const int xcd = wgid % 8, off = wgid / 8; wgid = xcd * 32 + off; }
        u.pm = (wgid >> 5) * 8 + (wgid & 7); u.pn = (wgid >> 3) & 3; u.kind = 0; u.ex = 0; u.nt = lda / 64;
        const char* a = A + (size_t)u.pm * 256 * lda * 2; const char* b = Bt + (size_t)u.pn * 256 * lda * 2;
        u.a0 = a; u.a1 = a + (size_t)128 * lda * 2; u.b0 = b; u.b1 = b + (size_t)128 * lda * 2; u.v00 = u.v01 = u.v10 = u.v11 = 0u;
        return true;
    }
};
DI pg::f32x4 bf4lo(pg::u32x4 w, int half) {
    const unsigned a = half ? w.z : w.x, b = half ? w.w : w.y;
    return (pg::f32x4){__uint_as_float(a << 16), __uint_as_float(a & 0xffff0000u), __uint_as_float(b << 16), __uint_as_float(b & 0xffff0000u)};
}
template <int MODE>
struct EpiMerge {
    u16* OUT; const u16* G; const u16* T1;
    DI void operator()(const pg::f32x4 (&acc)[2][2][4][2], const pg::Unit& u, int wr, int wc, int fr, int fq) const {
        const int c0 = u.pn * 256 + wc * 32 + 8 * fq;
#pragma unroll
        for (int ai = 0; ai < 2; ++ai)
#pragma unroll
            for (int m = 0; m < 4; ++m) { const size_t off = (size_t)(u.pm * 256 + ai * 128 + wr * 64 + m * 16 + fr) * 1024 + c0;
#pragma unroll
                for (int bj = 0; bj < 2; ++bj) {
                    const pg::u32x4 gw = *(const pg::u32x4*)(G + off + bj * 128);
                    pg::f32x4 v0 = acc[ai][bj][m][0] * bf4lo(gw, 0), v1 = acc[ai][bj][m][1] * bf4lo(gw, 1);
                    if (MODE == 1) { const pg::u32x4 tw = *(const pg::u32x4*)(T1 + off + bj * 128); v0 += bf4lo(tw, 0); v1 += bf4lo(tw, 1); }
                    pg::u32x4 w; w.x = pg::cvt_pk_bf16(v0[0], v0[1]); w.y = pg::cvt_pk_bf16(v0[2], v0[3]); w.z = pg::cvt_pk_bf16(v1[0], v1[1]); w.w = pg::cvt_pk_bf16(v1[2], v1[3]);
                    *(pg::u32x4*)(OUT + off + bj * 128) = w; } }
    }
};
struct EpiX1f {
    float* X1; const float* x; const float* MOD; float* SSP;
    DI void operator()(const pg::f32x4 (&acc)[2][2][4][2], const pg::Unit& u, int wr, int wc, int fr, int fq) const {
        const int c0 = u.pn * 256 + wc * 32 + 4 * fq;
        const float* g1 = MOD + (u.pm >> 4) * 6144 + 2048;
#pragma unroll
        for (int ai = 0; ai < 2; ++ai)
#pragma unroll
            for (int m = 0; m < 4; ++m) { const int row = u.pm * 256 + ai * 128 + wr * 64 + m * 16 + fr; const size_t off = (size_t)row * 1024 + c0;
                float ss = 0.f;
#pragma unroll
                for (int bj = 0; bj < 2; ++bj)
#pragma unroll
                    for (int n = 0; n < 2; ++n) { const int cc = bj * 128 + n * 16;
                        const pg::f32x4 xv = *(const pg::f32x4*)(x + off + cc), gv = *(const pg::f32x4*)(g1 + c0 + cc);
                        const pg::f32x4 o = xv + gv * acc[ai][bj][m][n];
                        ss += o[0] * o[0] + o[1] * o[1] + o[2] * o[2] + o[3] * o[3];
                        *(pg::f32x4*)(X1 + off + cc) = o; }
                ss += __shfl_xor(ss, 16); ss += __shfl_xor(ss, 32);
                if (fq == 0) SSP[(size_t)(u.pn * 4 + wc) * NT + row] = ss; }
    }
};
DI void ph_merge_ab(const Ctx& c, const Blk& B, unsigned char* lds_raw) {
    { SchedTile S{(const char*)c.out + FM_OUT_OFF, c.ws + WS_WFOT, 512, B.G, B.bid}; EpiMerge<0> E{(u16*)(c.ws + WS_T1), (const u16*)(c.ws + WS_GA), nullptr};
      pg::gemm_phase<true, false>((LAS unsigned char*)lds_raw, B.tid, 512, 512, S, E); }
    { SchedTile S{c.ws + WS_OB, c.ws + WS_WGOT, 1024, B.G, B.bid}; EpiMerge<1> E{(u16*)(c.ws + WS_M1), (const u16*)(c.ws + WS_GB), (const u16*)(c.ws + WS_T1)};
      pg::gemm_phase<true, false>((LAS unsigned char*)lds_raw, B.tid, 1024, 1024, S, E); }
}
DI void ph_merge_c(const Ctx& c, const Blk& B, unsigned char* lds_raw) {
    SchedTile S{c.ws + WS_M1, c.ws + WS_WMOT, 1024, B.G, B.bid}; EpiX1f E{c.out, c.x, (const float*)(c.ws + WS_MOD), (float*)(c.ws + WS_SSP)};
    pg::gemm_phase<false, false>((LAS unsigned char*)lds_raw, B.tid, 1024, 1024, S, E);
}

constexpr int MOE_TAB = 131072 + 1024;
DI void moe_tables256(const Ctx& c, const Blk& B, LAS int* T) {
    const int* cnt = (const int*)(c.ws + WS_CTL);
    __syncthreads();
    if (B.tid == 0) { int ts = 0; for (int e = 0; e < 32; ++e) { const int n = cnt[64 * e]; T[e] = ts; T[40 + e] = n; ts += (n + 255) >> 8; } T[32] = ts; }
    __syncthreads();
}
template <bool DOWN>
struct SchedMoE {
    const LAS int* T; const char* A; const char* W0; const char* W1; const int* TOKE; int G, c, tid;
    DI bool next(int i, pg::Unit& u) const {
        constexpr int NPN = DOWN ? 4 : 8;
        const int total = T[32] * NPN;
        int Lx = i * G + (c & 7) * (G >> 3) + (c >> 3);
        if (DOWN && i == total / G) Lx = i * G + c;
        if (Lx >= total) return false;
        const int tl = Lx / NPN, pn = Lx % NPN;
        int e = 0;
        for (int k = 1; k < 32; ++k) if (tl >= T[k]) e = k;
        const int mt = tl - T[e];
        u.pm = tl; u.pn = pn; u.kind = e; u.ex = mt; u.nt = 16;
        if (DOWN) {
            const char* a = A + (size_t)tl * 256 * 2048; const char* b = W0 + ((size_t)e * 1024 + pn * 256) * 2048;
            u.a0 = a; u.a1 = a + 128 * 2048; u.b0 = b; u.b1 = b + 128 * 2048; u.v00 = u.v01 = u.v10 = u.v11 = 0u;
        } else {
            const size_t wo = ((size_t)e * 1024 + pn * 128) * 2048;
            u.a0 = A; u.a1 = A; u.b0 = W0 + gate_off(e) + (size_t)pn * 128 * 2048; u.b1 = W0 + up_off(e) + (size_t)pn * 128 * 2048; (void)wo;
            const int n = T[40 + e], r0 = mt * 256; const int* tk = TOKE + e * CAP;
            int R0, C0, R1, C1; pg::lane_rc(tid, 0, R0, C0); pg::lane_rc(tid, 1, R1, C1);
            const int i00 = min(r0 + R0, n - 1), i01 = min(r0 + R1, n - 1), i10 = min(r0 + 128 + R0, n - 1), i11 = min(r0 + 128 + R1, n - 1);
            u.v00 = (unsigned)(tk[i00] * 1024 + C0) * 2u; u.v01 = (unsigned)(tk[i01] * 1024 + C1) * 2u;
            u.v10 = (unsigned)(tk[i10] * 1024 + C0) * 2u; u.v11 = (unsigned)(tk[i11] * 1024 + C1) * 2u;
        }
        return true;
    }
};
struct EpiGU {
    u16* ACT; const float* bg; const float* bu;
    DI void operator()(const pg::f32x4 (&acc)[2][2][4][2], const pg::Unit& u, int wr, int wc, int fr, int fq) const {
        const int col = u.pn * 128 + wc * 32 + 8 * fq;
        const float* pg_ = bg + u.kind * 1024 + col; const float* pu_ = bu + u.kind * 1024 + col;
        const pg::f32x4 bg0 = *(const pg::f32x4*)pg_, bg1 = *(const pg::f32x4*)(pg_ + 4), bu0 = *(const pg::f32x4*)pu_, bu1 = *(const pg::f32x4*)(pu_ + 4);
#pragma unroll
        for (int ai = 0; ai < 2; ++ai)
#pragma unroll
            for (int m = 0; m < 4; ++m) {
                float o[8];
#pragma unroll
                for (int n = 0; n < 2; ++n)
#pragma unroll
                    for (int j = 0; j < 4; ++j) {
                        const float gt = fminf(acc[ai][0][m][n][j] + (n ? bg1[j] : bg0[j]), 7.f);
                        const float up = fminf(fmaxf(acc[ai][1][m][n][j] + (n ? bu1[j] : bu0[j]), -7.f), 7.f);
                        o[n * 4 + j] = (up + 1.f) * gt / (1.f + __expf(-1.702f * gt));
                    }
                pg::u32x4 w; w.x = pg::cvt_pk_bf16(o[0], o[1]); w.y = pg::cvt_pk_bf16(o[2], o[3]); w.z = pg::cvt_pk_bf16(o[4], o[5]); w.w = pg::cvt_pk_bf16(o[6], o[7]);
                __builtin_nontemporal_store(w, (pg::u32x4*)(ACT + (size_t)(u.pm * 256 + ai * 128 + wr * 64 + m * 16 + fr) * 1024 + col));
            }
    }
};
struct EpiDown {
    u16* Y; const float* bd; const float* WTE;
    DI void operator()(const pg::f32x4 (&acc)[2][2][4][2], const pg::Unit& u, int wr, int wc, int fr, int fq) const {
        const int c0 = u.pn * 256 + wc * 32 + 8 * fq;
        const float* pb = bd + u.kind * 1024 + c0;
        pg::f32x4 b0[2], b1[2];
#pragma unroll
        for (int bj = 0; bj < 2; ++bj) { b0[bj] = *(const pg::f32x4*)(pb + bj * 128); b1[bj] = *(const pg::f32x4*)(pb + bj * 128 + 4); }
#pragma unroll
        for (int ai = 0; ai < 2; ++ai)
#pragma unroll
            for (int m = 0; m < 4; ++m) { const int rt = ai * 128 + wr * 64 + m * 16 + fr;
                const float wt = WTE[u.kind * CAP + u.ex * 256 + rt];
                u16* rowp = Y + (size_t)(u.pm * 256 + rt) * 1024 + c0;
#pragma unroll
                for (int bj = 0; bj < 2; ++bj) { const pg::f32x4 v0 = (acc[ai][bj][m][0] + b0[bj]) * wt, v1 = (acc[ai][bj][m][1] + b1[bj]) * wt;
                    pg::u32x4 w; w.x = pg::cvt_pk_bf16(v0[0], v0[1]); w.y = pg::cvt_pk_bf16(v0[2], v0[3]); w.z = pg::cvt_pk_bf16(v1[0], v1[1]); w.w = pg::cvt_pk_bf16(v1[2], v1[3]);
                    *(pg::u32x4*)(rowp + bj * 128) = w; } }
    }
};
DI void wprep_down_queue(const Ctx& c, const Blk& B, unsigned char* lds_raw) {
    float* scr = (float*)lds_raw + B.wave * 4160;
    LAS int* slot = (LAS int*)((LAS unsigned char*)lds_raw + 140000);
    unsigned* ctr = (unsigned*)c.ws + 2112;
    const int lane = B.lane;
    __syncthreads();
    if (B.tid == 0) *slot = (int)__hip_atomic_fetch_add(ctr, 1u, __ATOMIC_RELAXED, __HIP_MEMORY_SCOPE_AGENT);
    for (;;) {
        __syncthreads();
        const int bi = *slot;
        __syncthreads();
        if (bi >= 1024) break;
        int nextv = 0;
        if (B.tid == 0) nextv = (int)__hip_atomic_fetch_add(ctr, 1u, __ATOMIC_RELAXED, __HIP_MEMORY_SCOPE_AGENT);
        const int it = bi * 8 + B.wave, e = it >> 8, r = it & 255, nb = r >> 4, kb = r & 15;
        transpose64(c.w_down + (size_t)e * D * D + (size_t)(kb * 64) * D + nb * 64, (u16*)(c.ws + WS_WDT) + (size_t)e * D * D + (size_t)(nb * 64) * D + kb * 64, scr, lane);
        if (B.tid == 0) *slot = nextv;
    }
}
DI void ph_moe_gu(const Ctx& c, const Blk& B, unsigned char* lds_raw) {
    LAS int* T = (LAS int*)((LAS unsigned char*)lds_raw + MOE_TAB);
    moe_tables256(c, B, T);
    SchedMoE<false> S{T, c.ws + WS_H2, c.ws, c.ws + WS_WUT, (const int*)(c.ws + WS_TOKE), B.G, B.bid, B.tid};
    EpiGU E{(u16*)(c.ws + WS_ACT), c.b_gate, c.b_up};
    pg::gemm_phase<true, true>((LAS unsigned char*)lds_raw, B.tid, 1024, 1024, S, E);
}
DI void ph_moe_down(const Ctx& c, const Blk& B, unsigned char* lds_raw) {
    LAS int* T = (LAS int*)((LAS unsigned char*)lds_raw + MOE_TAB);
    moe_tables256(c, B, T);
    SchedMoE<true> S{T, c.ws + WS_ACT, c.ws + WS_WDT, nullptr, nullptr, B.G, B.bid, B.tid};
    EpiDown E{(u16*)(c.ws + WS_Y), c.b_down, (const float*)(c.ws + WS_WTE)};
    pg::gemm_phase<true, false>((LAS unsigned char*)lds_raw, B.tid, 1024, 1024, S, E);
}


typedef short bf16x8 __attribute__((ext_vector_type(8)));
typedef short bf16x4 __attribute__((ext_vector_type(4)));
typedef float f32x4 __attribute__((ext_vector_type(4)));
DI f32x4 mfma16(bf16x8 a, bf16x8 b, f32x4 c) { return __builtin_amdgcn_mfma_f32_16x16x32_bf16(a, b, c, 0, 0, 0); }
DI bf16x8 frag_nat(const LAS unsigned char* p) { return *(const LAS bf16x8*)p; }
DI bf16x8 frag_perm(const LAS unsigned char* p) {
    const bf16x4 lo = *(const LAS bf16x4*)p, hi = *(const LAS bf16x4*)(p + 32);
    return __builtin_shufflevector(lo, hi, 0, 1, 2, 3, 4, 5, 6, 7);
}
DI bf16x8 pack8(f32x4 a, f32x4 b) {
    typedef unsigned u32x4_ __attribute__((ext_vector_type(4)));
    u32x4_ w; w.x = pg::cvt_pk_bf16(a[0], a[1]); w.y = pg::cvt_pk_bf16(a[2], a[3]); w.z = pg::cvt_pk_bf16(b[0], b[1]); w.w = pg::cvt_pk_bf16(b[2], b[3]);
    return __builtin_bit_cast(bf16x8, w);
}
DI unsigned long long pack4(f32x4 a) { return (unsigned long long)pg::cvt_pk_bf16(a[0], a[1]) | ((unsigned long long)pg::cvt_pk_bf16(a[2], a[3]) << 32); }

constexpr int PL_Q = 0, PL_K = 17408, PL_KT = 36864, PL_VT = 55296, PL_KK = 92160, PL_G = 108544, PL_T01 = 110592, PL_T23 = 0;

#define DEF_N0(b_) ((b_) < 2 ? 31 : 37)
#define DEF_FLAG(d_) (4096 + 16 * (d_))
DI void ph_gdn_prep(const Ctx& c, const Blk& B, unsigned char* lds_raw, const int mode) {
    LAS unsigned char* lds = (LAS unsigned char*)lds_raw;
    const u16* QKV = (const u16*)(c.ws + WS_QKV); const float* BA = (const float*)(c.ws + WS_BA);
    const int tid = B.tid, lane = B.lane, wave = B.wave;
    for (int m = mode ? B.bid - 128 : B.bid; m < (mode ? 64 : 1024); m += (mode ? B.G - 128 : B.G)) {
        int b, n, hq;
        if (mode) { b = m >> 4; n = DEF_N0(b) + ((m >> 2) & 3); hq = m & 3; }
        else {
            const int r = m >> 4; b = (m >> 2) & 3; hq = m & 3;
            const int j = (r & 1) ? 32 + (r >> 1) : 31 - (r >> 1);
            n = j < DEF_N0(b) ? j : j + 4; }
        const bool isctx = n < 4;
        unsigned char* imgh = (unsigned char*)c.ws + WS_IMGH + (size_t)((b * 68 + n) * 4 + hq) * IMGH_STRIDE;
        {
            const int cg = tid & 127, run = tid >> 7, c0 = run * 16;
            const int gcol = cg < 32 ? (hq * 128 + cg * 4) : cg < 64 ? (512 + hq * 128 + (cg - 32) * 4) : (1024 + hq * 256 + (cg - 64) * 4);
            float w[9][4];
#pragma unroll
            for (int t = 0; t < 9; ++t) { const float4 wv = *(const float4*)(c.conv_w + t * 2048 + gcol); w[t][0] = wv.x; w[t][1] = wv.y; w[t][2] = wv.z; w[t][3] = wv.w; }
            int rb[3];
#pragma unroll
            for (int dr = 0; dr < 3; ++dr) {
                if (isctx) rb[dr] = (dr == 1) ? (NT + b * CT + n * 64) : -1;
                else { const int gr = (n - 4) + dr - 1; rb[dr] = (gr >= 0 && gr < 64) ? (b * L + gr * 64) : -1; }
            }
            const int cmin = isctx ? (n == 0 ? 0 : -1) : 0, cmax = isctx ? (n == 3 ? 63 : 64) : 63;
            float win[3][3][4];
#define LOADCOL(dst_dc, colv) do { _Pragma("unroll") for (int dr = 0; dr < 3; ++dr) { \
                const bool ok = rb[dr] >= 0 && (colv) >= cmin && (colv) <= cmax; \
                ushort4 x4 = make_ushort4(0, 0, 0, 0); if (ok) x4 = *(const ushort4*)(QKV + (size_t)(rb[dr] + (colv)) * 2048 + gcol); \
                win[dr][dst_dc][0] = bf2f(x4.x); win[dr][dst_dc][1] = bf2f(x4.y); win[dr][dst_dc][2] = bf2f(x4.z); win[dr][dst_dc][3] = bf2f(x4.w); } } while (0)
            LOADCOL(0, c0 - 1); LOADCOL(1, c0);
#pragma unroll
            for (int hf = 0; hf < 2; ++hf) {
                float outv[8][4];
#pragma unroll
                for (int i = 0; i < 8; ++i) {
                    LOADCOL(2, c0 + hf * 8 + i + 1);
#pragma unroll
                    for (int ch = 0; ch < 4; ++ch) {
                        float a = 0.f;
#pragma unroll
                        for (int dr = 0; dr < 3; ++dr)
#pragma unroll
                            for (int dc = 0; dc < 3; ++dc) a += win[dr][dc][ch] * w[dr * 3 + dc][ch];
                        outv[i][ch] = a / (1.f + __expf(-a));
                    }
#pragma unroll
                    for (int dr = 0; dr < 3; ++dr)
#pragma unroll
                        for (int ch = 0; ch < 4; ++ch) { win[dr][0][ch] = win[dr][1][ch]; win[dr][1][ch] = win[dr][2][ch]; }
                }
                const int cb0 = c0 + hf * 8;
                if ((wave & 1) == 0) {
#pragma unroll
                    for (int i = 0; i < 8; ++i) {
                        float ss = outv[i][0] * outv[i][0] + outv[i][1] * outv[i][1] + outv[i][2] * outv[i][2] + outv[i][3] * outv[i][3];
                        ss += __shfl_xor(ss, 1); ss += __shfl_xor(ss, 2); ss += __shfl_xor(ss, 4); ss += __shfl_xor(ss, 8); ss += __shfl_xor(ss, 16);
                        const float sc = rsqrtf(ss + EPS) * (lane < 32 ? 0.08838834764831845f : 1.f);
#pragma unroll
                        for (int ch = 0; ch < 4; ++ch) outv[i][ch] *= sc;
                    }
                    const int d0 = (lane & 31) * 4;
                    LAS unsigned char* nat = lds + (lane < 32 ? PL_Q : PL_K);
#pragma unroll
                    for (int i = 0; i < 8; ++i) *(LAS unsigned long long*)(nat + (cb0 + i) * 272 + d0 * 2) = pack4((f32x4){outv[i][0], outv[i][1], outv[i][2], outv[i][3]});
                    if (lane >= 32) {
#pragma unroll
                        for (int ch = 0; ch < 4; ++ch)
                            *(LAS bf16x8*)(lds + PL_KT + (d0 + ch) * 144 + cb0 * 2) = pack8((f32x4){outv[0][ch], outv[1][ch], outv[2][ch], outv[3][ch]}, (f32x4){outv[4][ch], outv[5][ch], outv[6][ch], outv[7][ch]});
                    }
                } else {
                    const int dv0 = (cg - 64) * 4;
#pragma unroll
                    for (int ch = 0; ch < 4; ++ch)
                        *(LAS bf16x8*)(lds + PL_VT + (dv0 + ch) * 144 + cb0 * 2) = pack8((f32x4){outv[0][ch], outv[1][ch], outv[2][ch], outv[3][ch]}, (f32x4){outv[4][ch], outv[5][ch], outv[6][ch], outv[7][ch]});
                }
                asm volatile("" ::: "memory");
            }
#undef LOADCOL
        }
        if (wave < 4) {
            const int hvl = wave >> 1, dir = wave & 1, hv = hq * 2 + hvl;
            const int row = isctx ? (NT + b * CT + n * 64 + lane) : (b * L + (n - 4) * 64 + lane);
            const float beta = 1.f / (1.f + expf(-BA[(size_t)row * 32 + dir * 8 + hv]));
            const float lg = -expf(c.a_log[dir * 8 + hv]) * softplusf_(BA[(size_t)row * 32 + 16 + dir * 8 + hv] + c.dt_bias[dir * 8 + hv]);
            float gc = lg;
            if (dir == 0) {
#pragma unroll
                for (int o = 1; o < 64; o <<= 1) { const float t = __shfl_up(gc, o); if (lane >= o) gc += t; }
            } else {
#pragma unroll
                for (int o = 1; o < 64; o <<= 1) { const float t = __shfl_down(gc, o); if (lane + o < 64) gc += t; }
            }
            const float ge = __shfl(gc, dir ? 0 : 63);
            LAS float* gl = (LAS float*)(lds + PL_G + wave * 512);
            gl[lane] = beta; gl[64 + lane] = gc;
            float* gi = (float*)((unsigned char*)c.ws + WS_IMGHD + (size_t)(((b * 68 + n) * 8 + hv) * 2 + dir) * IMGHD_STRIDE + ID_G);
            gi[lane] = expf(gc); gi[64 + lane] = expf(ge - gc); if (lane == 0) gi[128] = expf(ge);
        }
        __syncthreads();
        for (int ch = tid; ch < 1088 + 1152; ch += 512) {
            if (ch < 1088) *(pg::u32x4*)(imgh + IH_Q + ch * 16) = *(const LAS pg::u32x4*)(lds + PL_Q + ch * 16);
            else *(pg::u32x4*)(imgh + IH_KT + (ch - 1088) * 16) = *(const LAS pg::u32x4*)(lds + PL_KT + (ch - 1088) * 16);
        }
        {
            const int it = wave & 3, fr = lane & 15, qd = lane >> 4;
            const LAS unsigned char* xs = lds + (wave < 4 ? PL_K : PL_Q);
            bf16x8 xf[4];
#pragma unroll
            for (int ks = 0; ks < 4; ++ks) xf[ks] = frag_nat(xs + (it * 16 + fr) * 272 + ks * 64 + qd * 16);
            const int i = it * 16 + fr;
#pragma unroll
            for (int g = 0; g < 2; ++g) {
                f32x4 acc[2];
#pragma unroll
                for (int sub = 0; sub < 2; ++sub) {
                    acc[sub] = (f32x4){0.f, 0.f, 0.f, 0.f};
                    const int prow = 32 * g + 8 * (fr >> 2) + 4 * sub + (fr & 3);
#pragma unroll
                    for (int ks = 0; ks < 4; ++ks) acc[sub] = mfma16(frag_nat(lds + PL_K + prow * 272 + ks * 64 + qd * 16), xf[ks], acc[sub]);
                }
                const int j0 = 32 * g + 8 * qd;
                if (wave < 4) { *(LAS f32x4*)(lds + PL_KK + (i * 64 + j0) * 4) = acc[0]; *(LAS f32x4*)(lds + PL_KK + (i * 64 + j0 + 4) * 4) = acc[1]; }
                else {
#pragma unroll
                    for (int cb = 0; cb < 4; ++cb) {
                        const int dir = cb & 1, hv = hq * 2 + (cb >> 1);
                        const LAS float* gl = (const LAS float*)(lds + PL_G + cb * 512) + 64;
                        const float gi_ = gl[i]; const f32x4 gj0 = *(const LAS f32x4*)(gl + j0), gj1 = *(const LAS f32x4*)(gl + j0 + 4);
                        f32x4 o0, o1;
#pragma unroll
                        for (int r = 0; r < 4; ++r) { const int ja = j0 + r, jb = j0 + 4 + r; const bool ka = dir ? (ja >= i) : (ja <= i), kb = dir ? (jb >= i) : (jb <= i);
                            o0[r] = ka ? acc[0][r] * __expf(gi_ - gj0[r]) : 0.f; o1[r] = kb ? acc[1][r] * __expf(gi_ - gj1[r]) : 0.f; }
                        unsigned char* qki = (unsigned char*)c.ws + WS_IMGHD + (size_t)(((b * 68 + n) * 8 + hv) * 2 + dir) * IMGHD_STRIDE + ID_QK;
                        *(bf16x8*)(qki + i * 144 + j0 * 2) = pack8(o0, o1);
                    }
                }
            }
        }
        __syncthreads();
        if (wave < 4) {
            int dir = wave & 1, ln = lane; asm volatile("" : "+s"(dir), "+v"(ln));
            const LAS float* gl = (const LAS float*)(lds + PL_G + wave * 512);
            LAS unsigned char* tk = lds + (wave < 2 ? PL_T01 + wave * 18432 : PL_T23 + (wave - 2) * 18432);
            LAS float* Tf = (LAS float*)tk;
            const int q = ln >> 4, x = ln & 15;
#define TOKN(g_) (dir ? 63 - (g_) : (g_))
#define AFUN(gr_, gc_) (gl[TOKN(gr_)] * (*(const LAS float*)(lds + PL_KK + (TOKN(gr_) * 64 + TOKN(gc_)) * 4)) * __expf(gl[64 + TOKN(gr_)] - gl[64 + TOKN(gc_)]))
            {
                float Dc[16];
#pragma unroll
                for (int r = 0; r < 16; ++r) Dc[r] = (r == 0) ? ((x == 0) ? 1.f : 0.f) : 0.f;
#pragma unroll
                for (int r = 1; r < 16; ++r) {
                    float a = AFUN(16 * q + r, 16 * q + x);
                    a = (x < r) ? a : 0.f;
                    float s0 = 0.f, s1 = 0.f;
#pragma unroll
                    for (int m = 0; m < r; ++m) {
                        const float am = __uint_as_float((unsigned)__builtin_amdgcn_ds_bpermute(((ln & 48) + m) << 2, (int)__float_as_uint(a)));
                        if (m & 1) s1 += am * Dc[m]; else s0 += am * Dc[m];
                    }
                    Dc[r] = ((x == r) ? 1.f : 0.f) - (s0 + s1);
                }
#pragma unroll
                for (int r = 0; r < 16; ++r) Tf[(16 * q + r) * 64 + 16 * q + x] = Dc[r];
            }
            asm volatile("s_waitcnt lgkmcnt(0)" ::: "memory");
            f32x4 E10, E20, E21, E30, E31, E32;
#define EBLK(dst, r_, k_) do { dst = (f32x4){0.f, 0.f, 0.f, 0.f}; const f32x4 dr_ = *(const LAS f32x4*)(Tf + (16 * (r_) + x) * 64 + 16 * (r_) + 4 * q); \
                _Pragma("unroll") for (int s_ = 0; s_ < 4; ++s_) dst = __builtin_amdgcn_mfma_f32_16x16x4f32(AFUN(16 * (r_) + 4 * q + s_, 16 * (k_) + x), dr_[s_], dst, 0, 0, 0); } while (0)
            EBLK(E10, 1, 0); EBLK(E20, 2, 0); EBLK(E21, 2, 1); EBLK(E30, 3, 0); EBLK(E31, 3, 1); EBLK(E32, 3, 2);
#undef EBLK
#define TACC(acc, E_, k_, c_) do { _Pragma("unroll") for (int s_ = 0; s_ < 4; ++s_) acc = __builtin_amdgcn_mfma_f32_16x16x4f32(E_[s_], Tf[(16 * (k_) + 4 * q + s_) * 64 + 16 * (c_) + x], acc, 0, 0, 0); } while (0)
#define TSTORE(acc, r_, c_) do { _Pragma("unroll") for (int r2_ = 0; r2_ < 4; ++r2_) Tf[(16 * (r_) + 4 * q + r2_) * 64 + 16 * (c_) + x] = -acc[r2_]; } while (0)
            {
                f32x4 t10 = (f32x4){0.f, 0.f, 0.f, 0.f}, t21 = t10, t32 = t10;
                TACC(t10, E10, 0, 0); TACC(t21, E21, 1, 1); TACC(t32, E32, 2, 2);
                TSTORE(t10, 1, 0); TSTORE(t21, 2, 1); TSTORE(t32, 3, 2);
                asm volatile("s_waitcnt lgkmcnt(0)" ::: "memory");
                f32x4 t20 = (f32x4){0.f, 0.f, 0.f, 0.f}, t31 = t20;
                TACC(t20, E20, 0, 0); TACC(t20, E21, 1, 0); TACC(t31, E31, 1, 1); TACC(t31, E32, 2, 1);
                TSTORE(t20, 2, 0); TSTORE(t31, 3, 1);
                asm volatile("s_waitcnt lgkmcnt(0)" ::: "memory");
                f32x4 t30 = (f32x4){0.f, 0.f, 0.f, 0.f};
                TACC(t30, E30, 0, 0); TACC(t30, E31, 1, 0); TACC(t30, E32, 2, 0);
                TSTORE(t30, 3, 0);
                asm volatile("s_waitcnt lgkmcnt(0)" ::: "memory");
            }
#undef TACC
#undef TSTORE
#undef AFUN
            const int jn = TOKN(ln);
            const float gcj = gl[64 + jn], betaj = gl[jn];
            float Tc[64];
#pragma unroll
            for (int i = 0; i < 64; ++i) { const float v = Tf[i * 64 + ln]; Tc[i] = (i >= (ln & 48)) ? v : 0.f; }
            asm volatile("s_waitcnt lgkmcnt(0)" ::: "memory");
            const float sk_ = betaj * __expf(gcj), sv_ = betaj;
#pragma unroll
            for (int i = 0; i < 64; ++i) {
                const int in = TOKN(i);
                *(LAS u16*)(tk + in * 144 + jn * 2) = f2bf(Tc[i] * sk_);
                *(LAS u16*)(tk + 9216 + in * 144 + jn * 2) = f2bf(Tc[i] * sv_);
            }
#undef TOKN
        }
        __syncthreads();
        {
            const int cb = wave >> 1, typ = wave & 1, dir = cb & 1, hvl = cb >> 1, hv = hq * 2 + hvl, fr = lane & 15, qd = lane >> 4;
            const LAS unsigned char* tb = lds + (cb < 2 ? PL_T01 + cb * 18432 : PL_T23 + (cb - 2) * 18432) + typ * 9216;
            unsigned char* img = (unsigned char*)c.ws + WS_IMGHD + (size_t)(((b * 68 + n) * 8 + hv) * 2 + dir) * IMGHD_STRIDE;
            const int prm = 8 * (fr >> 2) + (fr & 3);
            bf16x8 tf[4][2];
#pragma unroll
            for (int it = 0; it < 4; ++it) { const int trow = typ ? (32 * (it >> 1) + prm + 4 * (it & 1)) : (it * 16 + fr);
#pragma unroll
                for (int ks = 0; ks < 2; ++ks) tf[it][ks] = frag_nat(tb + trow * 144 + ks * 64 + qd * 16); }
            const LAS unsigned char* xb = lds + (typ == 0 ? PL_KT : PL_VT + hvl * 128 * 144);
#pragma unroll
            for (int dg = 0; dg < 4; ++dg) {
                bf16x8 xf[2][2];
#pragma unroll
                for (int sub = 0; sub < 2; ++sub) { const int xrow = typ ? (32 * dg + 16 * sub + fr) : (32 * dg + prm + 4 * sub);
#pragma unroll
                    for (int ks = 0; ks < 2; ++ks) xf[sub][ks] = frag_nat(xb + xrow * 144 + ks * 64 + qd * 16); }
                if (typ == 0) {
#pragma unroll
                    for (int it = 0; it < 4; ++it) {
                        f32x4 a0 = (f32x4){0.f, 0.f, 0.f, 0.f}, a1 = a0;
#pragma unroll
                        for (int ks = 0; ks < 2; ++ks) { a0 = mfma16(xf[0][ks], tf[it][ks], a0); a1 = mfma16(xf[1][ks], tf[it][ks], a1); }
                        *(bf16x8*)(img + ID_W + (it * 16 + fr) * 272 + (32 * dg + 8 * qd) * 2) = pack8(-a0, -a1);
                    }
                } else {
#pragma unroll
                    for (int sub2 = 0; sub2 < 2; ++sub2)
#pragma unroll
                        for (int h = 0; h < 2; ++h) {
                            f32x4 a0 = (f32x4){0.f, 0.f, 0.f, 0.f}, a1 = a0;
#pragma unroll
                            for (int ks = 0; ks < 2; ++ks) { a0 = mfma16(tf[2 * h][ks], xf[sub2][ks], a0); a1 = mfma16(tf[2 * h + 1][ks], xf[sub2][ks], a1); }
                            *(bf16x8*)(img + ID_UT + (32 * dg + 16 * sub2 + fr) * 128 + (32 * h + 8 * qd) * 2) = pack8(a0, a1);
                        }
                }
            }
        }
        if (mode) asm volatile("s_waitcnt vmcnt(0)" ::: "memory");
        __syncthreads();
        if (mode && tid == 0) {
            __builtin_amdgcn_fence(__ATOMIC_RELEASE, "agent");
            __hip_atomic_store((unsigned*)c.ws + DEF_FLAG(m), 1u, __ATOMIC_RELEASE, __HIP_MEMORY_SCOPE_AGENT);
        }
    }
}

constexpr int SB_W = 0, SB_QK = 17408, SB_G = 26624, SB_Q = 27648, SB_KT = 45056, SB_BYTES = 63488;
DI void ph_gdn_scan(const Ctx& c, const Blk& B, unsigned char* lds_raw, int first) {
    const int me = B.bid - first;
    if (me < 0 || me >= 128) return;
    const int item = (me & 7) + 8 * (me >> 4), half = (me >> 3) & 1;
    LAS unsigned char* lds = (LAS unsigned char*)lds_raw;
    const int dir = item & 1, hv = (item >> 1) & 7, b = item >> 4, hq = hv >> 1;
    const bool cw = B.wave < 4;
    const int tid = B.tid, lane = B.lane, wave = B.wave, fr = lane & 15, qd = lane >> 4;
    const unsigned char* imgh0 = (const unsigned char*)c.ws + WS_IMGH; const unsigned char* imghd0 = (const unsigned char*)c.ws + WS_IMGHD;
    u16* O = (u16*)(c.ws + WS_O2);
#define CHUNK_OF(s) (dir ? ((s) < 4 ? 3 - (s) : 71 - (s)) : (s))
#define IMGH_OF(n) (imgh0 + (size_t)((b * 68 + (n)) * 4 + hq) * IMGH_STRIDE)
#define IMGHD_OF(n) (imghd0 + (size_t)(((b * 68 + (n)) * 8 + hv) * 2 + dir) * IMGHD_STRIDE)
#define DMA_STEP(n, buf) do { if (wave >= 4 && wave < 7) { const unsigned char* s_hd = IMGHD_OF(n); const unsigned char* s_h = IMGH_OF(n); \
        _Pragma("unroll") for (int it_ = 0; it_ < 21; ++it_) { const int p_ = it_ * 3 + (wave - 4); \
            if (p_ < 27) __builtin_amdgcn_global_load_lds((const unsigned*)(s_hd + p_ * 1024 + lane * 16), (LAS unsigned*)(lds + (buf) * SB_BYTES + p_ * 1024), 16, 0, 2); \
            else if (p_ < 62) __builtin_amdgcn_global_load_lds((const unsigned*)(s_h + (p_ - 27) * 1024 + lane * 16), (LAS unsigned*)(lds + (buf) * SB_BYTES + p_ * 1024), 16, 0, 0); } } } while (0)
#define STEP_BARRIER() do { if (wave == 7) asm volatile("s_waitcnt lgkmcnt(0)" ::: "memory"); else asm volatile("s_waitcnt vmcnt(0) lgkmcnt(0)" ::: "memory"); \
        __builtin_amdgcn_s_barrier(); asm volatile("" ::: "memory"); } while (0)
    f32x4 S[8];
#pragma unroll
    for (int dt = 0; dt < 8; ++dt) S[dt] = (f32x4){0.f, 0.f, 0.f, 0.f};
    const int dvc = half * 64 + (wave & 3) * 16 + fr;
    unsigned long long ucp[4];
#define REG_LOAD(n) do { const unsigned char* s_hd = IMGHD_OF(n); \
        _Pragma("unroll") for (int it_ = 0; it_ < 4; ++it_) ucp[it_] = *(const unsigned long long*)(s_hd + ID_UT + dvc * 128 + (it_ * 16 + qd * 4) * 2); } while (0)
    constexpr int OSTG = 2 * SB_BYTES + 1024;
#define OST_STORE(nprev, sb) do { if ((nprev) >= 4) { u16* orow_ = O + ((size_t)dir * NT + (size_t)b * L + (size_t)((nprev) - 4) * 64) * 1024 + hv * 128 + half * 64; \
        _Pragma("unroll") for (int j_ = 0; j_ < 8; ++j_) { const int ix_ = lane + 64 * j_, row_ = ix_ >> 3, ch_ = ix_ & 7; \
            *(pg::u32x4*)(orow_ + (size_t)row_ * 1024 + ch_ * 8) = *(const LAS pg::u32x4*)(lds + OSTG + (sb) * 8192 + row_ * 128 + ch_ * 16); } } } while (0)
    DMA_STEP(CHUNK_OF(0), 0);
    if (cw) REG_LOAD(CHUNK_OF(0));
    STEP_BARRIER();
    for (int s = 0; s < 68; ++s) {
        const int n = CHUNK_OF(s), buf = s & 1;
        const LAS unsigned char* lb = lds + buf * SB_BYTES;
        f32x4 u[4];
#pragma unroll
        for (int it = 0; it < 4; ++it) {
            const unsigned lo = (unsigned)ucp[it], hi = (unsigned)(ucp[it] >> 32);
            u[it] = (f32x4){__uint_as_float(lo << 16), __uint_as_float(lo & 0xffff0000u), __uint_as_float(hi << 16), __uint_as_float(hi & 0xffff0000u)};
        }
        if (wave == 7 && s > 0) OST_STORE(CHUNK_OF(s - 1), (s - 1) & 1);
        if (s == 29) {
            if (wave == 7) {
                const unsigned* fl = (const unsigned*)c.ws + DEF_FLAG(lane);
                while (__builtin_amdgcn_ballot_w64(__hip_atomic_load(fl, __ATOMIC_RELAXED, __HIP_MEMORY_SCOPE_AGENT) != 0u) != ~0ull) __builtin_amdgcn_s_sleep(2);
                __builtin_amdgcn_fence(__ATOMIC_ACQUIRE, "agent");
            }
        }
        if (s + 1 < 68) { const int n2 = CHUNK_OF(s + 1); DMA_STEP(n2, buf ^ 1); if (cw) REG_LOAD(n2); }
        if (cw) {
#define SBAR __builtin_amdgcn_sched_barrier(0)
#define LD_ROWS4(dst, base, rt0) do { _Pragma("unroll") for (int r_ = 0; r_ < 2; ++r_) _Pragma("unroll") for (int ks_ = 0; ks_ < 4; ++ks_) \
            dst[r_ * 4 + ks_] = frag_perm(lb + (base) + (((rt0) + r_) * 16 + fr) * 272 + (ks_ * 32 + qd * 4) * 2); } while (0)
#define LD_ROWS2(dst, base, rt0) do { _Pragma("unroll") for (int r_ = 0; r_ < 4; ++r_) _Pragma("unroll") for (int ks_ = 0; ks_ < 2; ++ks_) \
            dst[r_ * 2 + ks_] = frag_perm(lb + (base) + (((rt0) + r_) * 16 + fr) * 144 + (ks_ * 32 + qd * 4) * 2); } while (0)
        const LAS float* gb = (const LAS float*)(lb + SB_G);
        bf16x8 sf[4], fa[8], fb[8], fc[8];
#pragma unroll
        for (int ks = 0; ks < 4; ++ks) sf[ks] = pack8(S[2 * ks], S[2 * ks + 1]);
        f32x4 o[4];
        LD_ROWS4(fa, SB_W, 0);
        LD_ROWS4(fb, SB_W, 2);
        SBAR;
        LD_ROWS4(fc, SB_Q, 0);
#pragma unroll
        for (int r = 0; r < 2; ++r)
#pragma unroll
            for (int ks = 0; ks < 4; ++ks) u[r] = mfma16(fa[r * 4 + ks], sf[ks], u[r]);
        SBAR;
        LD_ROWS4(fa, SB_Q, 2);
#pragma unroll
        for (int r = 0; r < 2; ++r)
#pragma unroll
            for (int ks = 0; ks < 4; ++ks) u[2 + r] = mfma16(fb[r * 4 + ks], sf[ks], u[2 + r]);
        SBAR;
        LD_ROWS2(fb, SB_QK, 0);
#pragma unroll
        for (int r = 0; r < 2; ++r) { o[r] = (f32x4){0.f, 0.f, 0.f, 0.f};
#pragma unroll
            for (int ks = 0; ks < 4; ++ks) o[r] = mfma16(fc[r * 4 + ks], sf[ks], o[r]); }
        bf16x8 uf[2], upf[2];
        {
            f32x4 ek[4];
#pragma unroll
            for (int it = 0; it < 4; ++it) ek[it] = *(const LAS f32x4*)(gb + 64 + it * 16 + qd * 4);
#pragma unroll
            for (int ks = 0; ks < 2; ++ks) { uf[ks] = pack8(u[2 * ks], u[2 * ks + 1]); upf[ks] = pack8(u[2 * ks] * ek[2 * ks], u[2 * ks + 1] * ek[2 * ks + 1]); }
        }
        SBAR;
        LD_ROWS2(fc, SB_KT, 0);
#pragma unroll
        for (int r = 0; r < 2; ++r) { o[2 + r] = (f32x4){0.f, 0.f, 0.f, 0.f};
#pragma unroll
            for (int ks = 0; ks < 4; ++ks) o[2 + r] = mfma16(fa[r * 4 + ks], sf[ks], o[2 + r]); }
        SBAR;
        const float ege = gb[128];
        LD_ROWS2(fa, SB_KT, 4);
#pragma unroll
        for (int it = 0; it < 4; ++it) { o[it] *= *(const LAS f32x4*)(gb + it * 16 + qd * 4);
#pragma unroll
            for (int ks = 0; ks < 2; ++ks) o[it] = mfma16(fb[it * 2 + ks], uf[ks], o[it]); }
        SBAR;
#pragma unroll
        for (int dt = 0; dt < 4; ++dt) { S[dt] *= ege;
#pragma unroll
            for (int ks = 0; ks < 2; ++ks) S[dt] = mfma16(fc[dt * 2 + ks], upf[ks], S[dt]); }
        SBAR;
#pragma unroll
        for (int dt = 0; dt < 4; ++dt) { S[4 + dt] *= ege;
#pragma unroll
            for (int ks = 0; ks < 2; ++ks) S[4 + dt] = mfma16(fa[dt * 2 + ks], upf[ks], S[4 + dt]); }
#undef SBAR
#undef LD_ROWS4
#undef LD_ROWS2
        if (n >= 4) {
            LAS unsigned char* sg = lds + OSTG + (s & 1) * 8192 + ((wave & 3) * 16 + fr) * 2;
#pragma unroll
            for (int it = 0; it < 4; ++it)
#pragma unroll
                for (int r = 0; r < 4; ++r) *(LAS u16*)(sg + (it * 16 + qd * 4 + r) * 128) = f2bf(o[it][r]);
        }
        }
        STEP_BARRIER();
    }
    if (wave == 7) OST_STORE(CHUNK_OF(67), 67 & 1);
    asm volatile("s_waitcnt vmcnt(0)" ::: "memory");
#undef CHUNK_OF
#undef IMGH_OF
#undef IMGHD_OF
#undef DMA_STEP
#undef REG_LOAD
#undef OST_STORE
#undef STEP_BARRIER
}

DI void ph_mergeprep2(const Ctx& c, const Blk& B) {
    const u16* O = (const u16*)(c.ws + WS_O2); const u16* SZ = (const u16*)(c.ws + WS_SZ); u16* OB = (u16*)(c.ws + WS_OB);
    for (int row = B.bid * 8 + B.wave; row < NT; row += B.G * 8) {
        const int c0 = B.lane * 16;
        const uint4 a0 = *(const uint4*)(O + (size_t)row * 1024 + c0), a1 = *(const uint4*)(O + (size_t)row * 1024 + c0 + 8);
        const uint4 b0 = *(const uint4*)(O + ((size_t)NT + row) * 1024 + c0), b1 = *(const uint4*)(O + ((size_t)NT + row) * 1024 + c0 + 8);
        const uint4 z0 = *(const uint4*)(SZ + (size_t)row * 1024 + c0), z1 = *(const uint4*)(SZ + (size_t)row * 1024 + c0 + 8);
        const unsigned aw[8] = {a0.x, a0.y, a0.z, a0.w, a1.x, a1.y, a1.z, a1.w}, bw[8] = {b0.x, b0.y, b0.z, b0.w, b1.x, b1.y, b1.z, b1.w}, zw[8] = {z0.x, z0.y, z0.z, z0.w, z1.x, z1.y, z1.z, z1.w};
        float o[16]; float ss = 0.f;
#pragma unroll
        for (int i = 0; i < 8; ++i) { o[2 * i] = __uint_as_float(aw[i] << 16) + __uint_as_float(bw[i] << 16); o[2 * i + 1] = __uint_as_float(aw[i] & 0xffff0000u) + __uint_as_float(bw[i] & 0xffff0000u); ss += o[2 * i] * o[2 * i] + o[2 * i + 1] * o[2 * i + 1]; }
#ifdef DBG_SANITIZE
        ss = 0.f;
#pragma unroll
        for (int i = 0; i < 16; ++i) { if (!(fabsf(o[i]) < 1e30f)) o[i] = 0.f; ss += o[i] * o[i]; }
#endif
        ss += __shfl_xor(ss, 1); ss += __shfl_xor(ss, 2); ss += __shfl_xor(ss, 4);
        const float rs = rsqrtf(ss * (1.f / 128.f) + EPS);
        unsigned ow[8];
#pragma unroll
        for (int i = 0; i < 8; ++i) { const int ch = (c0 + 2 * i) & 127;
            ow[i] = pg::cvt_pk_bf16(o[2 * i] * rs * c.gdn_norm_g[ch] * __uint_as_float(zw[i] << 16), o[2 * i + 1] * rs * c.gdn_norm_g[ch + 1] * __uint_as_float(zw[i] & 0xffff0000u)); }
        *(uint4*)(OB + (size_t)row * 1024 + c0) = make_uint4(ow[0], ow[1], ow[2], ow[3]); *(uint4*)(OB + (size_t)row * 1024 + c0 + 8) = make_uint4(ow[4], ow[5], ow[6], ow[7]);
    }
}

constexpr size_t WS_WRT = WS_MOD + 256 * 1024;
constexpr size_t WS_RC = WS_MOD + 128 * 1024;
DI void ph_router_const(const Ctx& c, const Blk& B) {
    if (B.bid >= 16) {
        if (B.bid < 80) {
            float* WRT = (float*)(c.ws + WS_WRT);
#pragma unroll
            for (int j = 0; j < 4; ++j) { const int idx = (B.bid - 16) * 512 + B.tid + 32768 * j, b = idx >> 15, k = (idx >> 5) & 1023, e = idx & 31;
                WRT[(size_t)(b * 32 + e) * 1024 + k] = c.w_router[k * 32 + e] * (c.norm2_g[k] * (1.f + ((const float*)(c.ws + WS_MOD))[b * 6144 + 4096 + k])); }
        }
        return;
    }
    const int idx = B.bid * 8 + B.wave, b = idx >> 5, e = idx & 31;
    const float* sh = (const float*)(c.ws + WS_MOD) + b * 6144 + 3072;
    float s = 0.f;
#pragma unroll 4
    for (int j = 0; j < 16; ++j) { const int k = B.lane + 64 * j; s += sh[k] * c.w_router[(size_t)k * 32 + e]; }
    s = wave_sum(s);
    if (B.lane == 0) ((float*)(c.ws + WS_RC))[idx] = s + c.b_router[e];
}
DI void ph_router_fast(const Ctx& c, const Blk& B, unsigned char* lds_raw) {
    const float* X1 = c.out; const float* MOD = (const float*)(c.ws + WS_MOD); u16* H2 = (u16*)(c.ws + WS_H2); const float* SSP = (const float*)(c.ws + WS_SSP);
    int* cnt = (int*)(c.ws + WS_CTL); int* TOKE = (int*)(c.ws + WS_TOKE); float* WTE = (float*)(c.ws + WS_WTE); int* TOPE = (int*)(c.ws + WS_TOPE); int* TOPP = (int*)(c.ws + WS_TOPP);
    LAS unsigned* arr = (LAS unsigned*)((LAS unsigned char*)lds_raw + 133120);
    const int lane = B.lane, i = lane & 15, kq = lane >> 4;
    for (int tb = B.bid; tb < NT / 64; tb += B.G) {
        __syncthreads();
        if (B.tid < 4) arr[B.tid] = 0u;
        __syncthreads();
        const int tok0 = tb * 64, b = tok0 / L;
        const float* g2 = c.norm2_g; const float* sh = MOD + b * 6144 + 3072; const float* sc = MOD + b * 6144 + 4096;
        if (B.wave >= 4) {
            const int r0 = tok0 + (B.wave - 4) * 16;
            f32x4 G[4], S[4];
#pragma unroll
            for (int j = 0; j < 4; ++j) { const f32x4 g = *(const f32x4*)(g2 + (lane + 64 * j) * 4), s = *(const f32x4*)(sc + (lane + 64 * j) * 4); G[j] = g * (s + 1.f); S[j] = *(const f32x4*)(sh + (lane + 64 * j) * 4); }
            float rsd;
            { const float* sp = SSP + (size_t)(4 * kq) * NT + r0 + i; float ssv = ((sp[0] + sp[NT]) + sp[2 * NT]) + sp[3 * NT];
              ssv += __shfl_xor(ssv, 16); ssv += __shfl_xor(ssv, 32); rsd = rsqrtf(ssv * (1.f / D) + EPS); }
#pragma unroll
            for (int rb = 0; rb < 16; rb += 8) {
                f32x4 v[8][4];
#pragma unroll
                for (int r = 0; r < 8; ++r)
#pragma unroll
                    for (int j = 0; j < 4; ++j) v[r][j] = *(const f32x4*)(X1 + (size_t)(r0 + rb + r) * D + (lane + 64 * j) * 4);
#pragma unroll
                for (int r = 0; r < 8; ++r) {
                    const float rstd = __builtin_bit_cast(float, __builtin_amdgcn_readlane(__builtin_bit_cast(int, rsd), rb + r));
#pragma unroll
                    for (int j = 0; j < 4; ++j) *(unsigned long long*)(H2 + (size_t)(r0 + rb + r) * D + (lane + 64 * j) * 4) = pack4(v[r][j] * rstd * G[j] + S[j]);
                }
            }
            continue;
        }
        const int w = B.wave, ks = w * 256;
        LAS float* xs = (LAS float*)lds_raw + w * 4160;
        LAS unsigned* hist = (LAS unsigned*)(xs + 3760);
        if (lane < 32) hist[lane] = 0u;
        float wa[64], wb[64];
        { const float* wt = (const float*)(c.ws + WS_WRT) + (size_t)(b * 32 + i) * 1024 + ks + 16 * kq;
#pragma unroll
          for (int c4 = 0; c4 < 4; ++c4)
#pragma unroll
            for (int s4 = 0; s4 < 4; ++s4) {
                const float4 A = *(const float4*)(wt + 64 * c4 + 4 * s4), Bv = *(const float4*)(wt + 16 * 1024 + 64 * c4 + 4 * s4);
                const int o = (c4 * 4 + s4) * 4;
                wa[o] = A.x; wa[o + 1] = A.y; wa[o + 2] = A.z; wa[o + 3] = A.w; wb[o] = Bv.x; wb[o + 1] = Bv.y; wb[o + 2] = Bv.z; wb[o + 3] = Bv.w;
            } }
        const float* xu = X1 + (size_t)tok0 * D + ks;
        const int lo = (lane >> 4) * D + (lane & 15) * 4;
        constexpr int NPF = 2;
        f32x4 xr[NPF][4];
#pragma unroll
        for (int p = 0; p < NPF; ++p)
#pragma unroll
            for (int t = 0; t < 4; ++t) xr[p][t] = *(const f32x4*)(xu + ((16 * (p >> 2) + 4 * t) * D + 64 * (p & 3)) + lo);
        f32x4 a0 = (f32x4){0.f, 0.f, 0.f, 0.f}, a1 = (f32x4){0.f, 0.f, 0.f, 0.f};
#pragma unroll
        for (int p = 0; p < 16; ++p) {
            const int g = p >> 2, c4 = p & 3;
#pragma unroll
            for (int t = 0; t < 4; ++t) *(LAS f32x4*)(xs + (4 * t + (lane >> 4)) * 68 + (lane & 15) * 4) = xr[p % NPF][t];
            if (p + NPF < 16) {
#pragma unroll
                for (int t = 0; t < 4; ++t) xr[p % NPF][t] = *(const f32x4*)(xu + ((16 * ((p + NPF) >> 2) + 4 * t) * D + 64 * ((p + NPF) & 3)) + lo);
            }
            asm volatile("s_waitcnt lgkmcnt(0)" ::: "memory");
#pragma unroll
            for (int s4 = 0; s4 < 4; ++s4) {
                const f32x4 v = *(const LAS f32x4*)(xs + i * 68 + kq * 16 + 4 * s4);
#pragma unroll
                for (int q = 0; q < 4; ++q) {
                    a0 = __builtin_amdgcn_mfma_f32_16x16x4f32(v[q], wa[(c4 * 4 + s4) * 4 + q], a0, 0, 0, 0);
                    a1 = __builtin_amdgcn_mfma_f32_16x16x4f32(v[q], wb[(c4 * 4 + s4) * 4 + q], a1, 0, 0, 0);
                }
            }
            asm volatile("" ::: "memory");
            if (c4 == 3) {
                LAS float* P = (LAS float*)lds_raw + g * 4160 + 1088 + w * 528;
#pragma unroll
                for (int r = 0; r < 4; ++r) { P[(4 * kq + r) * 33 + i] = a0[r]; P[(4 * kq + r) * 33 + 16 + i] = a1[r]; }
                asm volatile("s_waitcnt lgkmcnt(0)" ::: "memory");
                if (lane == 0) __hip_atomic_fetch_add(arr + g, 1u, __ATOMIC_RELEASE, __HIP_MEMORY_SCOPE_WORKGROUP);
                a0 = (f32x4){0.f, 0.f, 0.f, 0.f}; a1 = (f32x4){0.f, 0.f, 0.f, 0.f};
            }
        }
        while (__hip_atomic_load(arr + w, __ATOMIC_ACQUIRE, __HIP_MEMORY_SCOPE_WORKGROUP) < 4u) __builtin_amdgcn_s_sleep(1);
        asm volatile("s_waitcnt lgkmcnt(0)" ::: "memory");
        const int row0 = tok0 + 16 * w;
        float ssv;
        { const float* sp = SSP + (size_t)(4 * kq) * NT + row0 + i; ssv = ((sp[0] + sp[NT]) + sp[2 * NT]) + sp[3 * NT]; }
        ssv += __shfl_xor(ssv, 16); ssv += __shfl_xor(ssv, 32);
        const float rstd = rsqrtf(ssv * (1.f / D) + EPS);
        LAS float* Pm = xs + 1088;
        LAS float* lg = xs + 3200;
        const float* RC = (const float*)(c.ws + WS_RC) + b * 32;
#pragma unroll
        for (int e8 = 0; e8 < 8; ++e8) { const int e = 8 * kq + e8, o = i * 33 + e;
            lg[i * 34 + e] = (((Pm[o] + Pm[528 + o]) + Pm[1056 + o]) + Pm[1584 + o]) * rstd + RC[e]; }
        asm volatile("s_waitcnt lgkmcnt(0)" ::: "memory");
        int sidx[4] = {0, 0, 0, 0}, slp[4] = {0, 0, 0, 0}, strow = 0; float sw[4] = {0.f, 0.f, 0.f, 0.f};
        if (B.lane < 16) {
            float l_[32];
#pragma unroll
            for (int e = 0; e < 32; e += 2) { const pg::f32x2_ t = *(const LAS pg::f32x2_*)(lg + B.lane * 34 + e); l_[e] = t[0]; l_[e + 1] = t[1]; }
            int idx[4]; float val[4];
#pragma unroll
            for (int j = 0; j < 4; ++j) {
                float best = -3.0e38f; int bi = 0;
#pragma unroll
                for (int e = 0; e < 32; ++e) { const bool taken = (j > 0 && idx[0] == e) || (j > 1 && idx[1] == e) || (j > 2 && idx[2] == e); if (!taken && l_[e] > best) { best = l_[e]; bi = e; } }
                idx[j] = bi; val[j] = best;
            }
            float wv[4], den = 0.f;
#pragma unroll
            for (int j = 0; j < 4; ++j) { wv[j] = expf(val[j] - val[0]); den += wv[j]; }
            int lp[4];
#pragma unroll
            for (int j = 0; j < 4; ++j) lp[j] = (int)__hip_atomic_fetch_add((LAS unsigned*)hist + idx[j], 1u, __ATOMIC_RELAXED, __HIP_MEMORY_SCOPE_WORKGROUP);
            asm volatile("s_waitcnt lgkmcnt(0)" ::: "memory");
            sidx[0] = idx[0]; sidx[1] = idx[1]; sidx[2] = idx[2]; sidx[3] = idx[3]; slp[0] = lp[0]; slp[1] = lp[1]; slp[2] = lp[2]; slp[3] = lp[3];
            sw[0] = wv[0] / den; sw[1] = wv[1] / den; sw[2] = wv[2] / den; sw[3] = wv[3] / den; strow = row0 + B.lane;
        }
        asm volatile("s_waitcnt lgkmcnt(0)" ::: "memory");
        if (B.lane < 32) { const unsigned n = hist[B.lane]; unsigned base = 0u; if (n) base = (unsigned)atomicAdd(&cnt[64 * B.lane], (int)n); hist[32 + B.lane] = base; }
        asm volatile("s_waitcnt vmcnt(0) lgkmcnt(0)" ::: "memory");
        if (B.lane < 16) {
#pragma unroll
            for (int j = 0; j < 4; ++j) {
                const int e = sidx[j]; const int pos = (int)hist[32 + e] + slp[j];
                TOKE[e * CAP + pos] = strow; WTE[e * CAP + pos] = sw[j]; TOPE[strow * 4 + j] = e; TOPP[strow * 4 + j] = pos;
            }
        }
        asm volatile("s_waitcnt lgkmcnt(0)" ::: "memory");
    }
}


DI void ph_dftm2(const Ctx& c, const Blk& B, float* lds) {
    u16* CS = (u16*)c.out;
    const size_t n8 = (size_t)2 * 2048 * 2048 / 8;
    for (size_t i = (size_t)B.bid * 512 + B.tid; i < n8; i += (size_t)B.G * 512) {
        const int which = (int)(i >> 19), r = (int)(i & 524287), k = r >> 8, l0 = (r & 255) * 8, ph = which ? 3072 : 0;
        unsigned w[4];
#pragma unroll
        for (int q = 0; q < 4; ++q) {
            const float lo = cos_rev(((k * (l0 + 2 * q)) + ph) & 4095, 1.f / 4096.f), hi = cos_rev(((k * (l0 + 2 * q + 1)) + ph) & 4095, 1.f / 4096.f);
            w[q] = (unsigned)f2bf(lo) | ((unsigned)f2bf(hi) << 16);
        }
        *(uint4*)(CS + i * 8) = make_uint4(w[0], w[1], w[2], w[3]);
    }
    __syncthreads();
}
DI void ph_dft_edge(const Ctx& c, const Blk& B) {
    const u16* WFT = (const u16*)(c.ws + WS_WFT); const u16* FE = (const u16*)((const char*)c.out + FE_OUT_OFF); float* NYQ = (float*)(c.ws + WS_NYQ);
    for (int n = B.bid * 8 + B.wave; n < 2048; n += B.G * 8) {
        const int b = n >> 9, gm = n & 511;
        const u16* ur = (const u16*)(c.ws + WS_NYQ + 16384) + (size_t)b * D; const u16* wr = WFT + (size_t)gm * D;
        float f = 0.f, nyq = 0.f;
#pragma unroll
        for (int j = 0; j < 2; ++j) {
            const uint4 a = *(const uint4*)(ur + (B.lane + 64 * j) * 8), w = *(const uint4*)(wr + (B.lane + 64 * j) * 8);
            const unsigned aw[4] = {a.x, a.y, a.z, a.w}, ww[4] = {w.x, w.y, w.z, w.w};
#pragma unroll
            for (int q = 0; q < 4; ++q) f += __uint_as_float(aw[q] << 16) * __uint_as_float(ww[q] << 16) + __uint_as_float(aw[q] & 0xffff0000u) * __uint_as_float(ww[q] & 0xffff0000u);
        }
#pragma unroll
        for (int j = 0; j < 4; ++j) {
            const uint4 e = *(const uint4*)(FE + (size_t)n * 4096 + (B.lane + 64 * j) * 8);
            const unsigned ew[4] = {e.x, e.y, e.z, e.w};
#pragma unroll
            for (int q = 0; q < 4; ++q) nyq += __uint_as_float(ew[q] << 16) - __uint_as_float(ew[q] & 0xffff0000u);
        }
        f = wave_sum(f); nyq = wave_sum(nyq);
        if (B.lane == 0) { NYQ[n] = nyq + f; NYQ[2048 + n] = f; ((u16*)((char*)c.out + FM_OUT_OFF))[((size_t)(n >> 9) * 4096 + 2048) * 512 + (n & 511)] = f2bf((nyq + f) * (1.f / 724.0773439350247f)); }
    }
}
struct SchedDFT2 {
    const char* CS; const char* FE; int c, first, kind;
    DI bool next(int i, pg::Unit& u) const {
        const int me = c - first; if (i != 0 || me < 0 || me >= 64) return false;
        const int idx = me;
        u.pm = idx >> 3; u.pn = idx & 7; u.kind = kind; u.ex = 0; u.nt = 32;
        const char* a = CS + (size_t)kind * 2048 * 4096 + (size_t)u.pm * 256 * 4096; const char* b = FE + (size_t)u.pn * 256 * 8192 + (size_t)kind * 4096;
        u.a0 = a; u.a1 = a + 128 * 4096; u.b0 = b; u.b1 = b + 128 * 8192; u.v00 = u.v01 = u.v10 = u.v11 = 0u;
        return true;
    }
};
struct EpiDFT2 {
    float* PC; u16* FM; const float* NYQ;
    DI void operator()(const pg::f32x4 (&acc)[2][2][4][2], const pg::Unit& u, int wr, int wc, int fr, int fq) const {
        const int nc0 = u.pn * 256 + wc * 32 + 4 * fq;
        const unsigned pbase = (unsigned)(u.pm * 256 * 2048 + nc0);
        if (u.kind == 0) {
#pragma unroll
            for (int ai = 0; ai < 2; ++ai)
#pragma unroll
                for (int m = 0; m < 4; ++m) { const unsigned ro = pbase + (unsigned)(ai * 128 + wr * 64 + m * 16 + fr) * 2048u;
#pragma unroll
                    for (int bj = 0; bj < 2; ++bj)
#pragma unroll
                        for (int n = 0; n < 2; ++n) *(pg::f32x4*)(PC + ro + bj * 128 + n * 16) = acc[ai][bj][m][n]; }
            return;
        }
        const float scale = 1.f / 724.0773439350247f;
#pragma unroll
        for (int ai = 0; ai < 2; ++ai)
#pragma unroll
            for (int m = 0; m < 4; ++m) { const int rl = ai * 128 + wr * 64 + m * 16 + fr, k = u.pm * 256 + rl; const unsigned ro = pbase + (unsigned)rl * 2048u;
                const float sg = (k & 1) ? -1.f : 1.f;
#pragma unroll
                for (int bj = 0; bj < 2; ++bj)
#pragma unroll
                    for (int n = 0; n < 2; ++n) { const int off = bj * 128 + n * 16;
                        const int nc = nc0 + off, bb = nc >> 9, gm = nc & 511;
                        const pg::f32x4 pc = *(const pg::f32x4*)(PC + ro + off), f = *(const pg::f32x4*)(NYQ + 2048 + nc), ps = acc[ai][bj][m][n];
                        const pg::f32x4 bs = pc + f * sg, y0 = (bs - ps) * scale, y1 = (bs + ps) * scale;
                        const unsigned o0 = (unsigned)((bb * 4096 + k) * 512 + gm), o1 = (unsigned)((bb * 4096 + (4096 - k)) * 512 + gm);
                        *(uint2*)(FM + o0) = make_uint2(pg::cvt_pk_bf16(y0[0], y0[1]), pg::cvt_pk_bf16(y0[2], y0[3]));
                        if (k >= 1) *(uint2*)(FM + o1) = make_uint2(pg::cvt_pk_bf16(y1[0], y1[1]), pg::cvt_pk_bf16(y1[2], y1[3]));
                        if (n == 1) asm volatile("" ::: "memory");
                    } }
    }
};
DI void ph_dft2(const Ctx& c, const Blk& B, unsigned char* lds_raw, int first) {
    EpiDFT2 E{(float*)((char*)c.out + 16 * MiB), (u16*)((char*)c.out + FM_OUT_OFF), (const float*)(c.ws + WS_NYQ)};
    { SchedDFT2 S{(const char*)c.out, (const char*)c.out + FE_OUT_OFF, B.bid, first, 0}; pg::gemm_phase<false, false>((LAS unsigned char*)lds_raw, B.tid, 2048, 4096, S, E); }
    asm volatile("s_waitcnt vmcnt(0)" ::: "memory");
    { SchedDFT2 S{(const char*)c.out, (const char*)c.out + FE_OUT_OFF, B.bid, first, 1}; pg::gemm_phase<false, false>((LAS unsigned char*)lds_raw, B.tid, 2048, 4096, S, E); }
}
#define XB_TMO      128
#define XB_XCNT(j)  (256  + 64 * (j))
#define XB_XSUB(j)  (1280 + 64 * (j))
#define XB_XGEN(j)  (2304 + 64 * (j))
#define XB_TOP      3328
#define XB_TOPGEN   3392
#define XB_SPIN_CAP (1u << 18)
constexpr int XB_BASE = 8192;
constexpr int XB_LDS_OFF = 147456;
DI unsigned xb_ld(unsigned* p)              { return __hip_atomic_load(p, __ATOMIC_RELAXED, __HIP_MEMORY_SCOPE_AGENT); }
DI unsigned xb_add(unsigned* p, unsigned v) { return __hip_atomic_fetch_add(p, v, __ATOMIC_RELAXED, __HIP_MEMORY_SCOPE_AGENT); }
DI unsigned xb_xcc_id() { return (unsigned)__builtin_amdgcn_s_getreg((3 << 11) | 20) & 0xFu; }
#define XB_SPIN(cond, bar) do { unsigned _sp = 0; while (cond) { __builtin_amdgcn_s_sleep(1); \
    if ((++_sp & 255u) == 0u) { if (xb_ld(&(bar)[XB_TMO])) break; if (_sp > XB_SPIN_CAP) { atomicAdd(&(bar)[XB_TMO], 1u); break; } } } } while (0)
DI void xcd_barrier_complete(unsigned* bar, unsigned x, unsigned& nloc, unsigned& nx) {
    const unsigned G = gridDim.x;
    unsigned sum, cnt, mine, sp = 0u;
    for (;;) {
        sum = 0u; cnt = 0u; mine = 0u;
#pragma unroll
        for (unsigned j = 0; j < 16; ++j) { const unsigned c = xb_ld(&bar[XB_XCNT(j)]); sum += c; cnt += (c > 0u) ? 1u : 0u; mine = (j == x) ? c : mine; }
        if (sum == G) break;
        __builtin_amdgcn_s_sleep(1);
        if ((++sp & 255u) == 0u) { if (xb_ld(&bar[XB_TMO])) break; if (sp > XB_SPIN_CAP) { atomicAdd(&bar[XB_TMO], 1u); break; } }
    }
    nloc = mine > 0u ? mine : 1u; nx = cnt > 0u ? cnt : 1u;
}
DI void xcd_barrier(unsigned* bar, volatile LAS unsigned* st, int tid) {
    asm volatile("s_waitcnt vmcnt(0)" ::: "memory");
    __syncthreads();
    if (tid == 0) {
        const unsigned x = xb_xcc_id();
        __builtin_amdgcn_s_waitcnt(0);
        unsigned nloc = st[0], nx = st[1];
        if (nloc == 0u) { xcd_barrier_complete(bar, x, nloc, nx); st[0] = nloc; st[1] = nx; }
        const unsigned old = xb_add(&bar[XB_XSUB(x)], 1u);
        const unsigned gen = old / nloc;
        if (old + 1u == (gen + 1u) * nloc) {
            __builtin_amdgcn_fence(__ATOMIC_RELEASE, "agent");
            asm volatile("s_waitcnt vmcnt(0)" ::: "memory");
            const unsigned og = xb_add(&bar[XB_TOP], 1u);
            const unsigned tg = og / nx;
            if (og + 1u == (tg + 1u) * nx) xb_add(&bar[XB_TOPGEN], 1u);
            else XB_SPIN(xb_ld(&bar[XB_TOPGEN]) == tg, bar);
            __builtin_amdgcn_fence(__ATOMIC_ACQUIRE, "agent");
            xb_add(&bar[XB_XGEN(x)], 1u);
            asm volatile("s_waitcnt vmcnt(0)" ::: "memory");
        } else {
            XB_SPIN(xb_ld(&bar[XB_XGEN(x)]) == gen, bar);
            __builtin_amdgcn_fence(__ATOMIC_ACQUIRE, "agent");
            asm volatile("s_waitcnt vmcnt(0)" ::: "memory");
        }
    }
    __syncthreads();
}

constexpr int LDS_BYTES = 147456 + 256;
__global__ void __launch_bounds__(512, 2) mega(Ctx carg) {
    extern __shared__ __attribute__((aligned(16))) unsigned char lds_raw[];
    float* lds = (float*)lds_raw;
    const int wv0 = __builtin_amdgcn_readfirstlane((int)threadIdx.x >> 6);
#define WSP(T, off) ((T*)(c.ws + (off)))
    {
        volatile LAS unsigned* st = (volatile LAS unsigned*)((LAS unsigned char*)lds_raw + XB_LDS_OFF);
        if (threadIdx.x < 4) st[threadIdx.x] = 0u;
        __syncthreads();
        if (threadIdx.x == 0) { const Ctx& c = ctx(); (void)xb_add((unsigned*)c.ws + XB_BASE + XB_XCNT(xb_xcc_id()), 1u); }
    }
#define GSYNC() do { const Ctx& c_ = ctx(); const Blk B_ = mkblk(wv0); xcd_barrier((unsigned*)c_.ws + XB_BASE, (volatile LAS unsigned*)((LAS unsigned char*)lds_raw + XB_LDS_OFF), B_.tid); } while (0)

    { const Ctx& c = ctx(); const Blk B = mkblk(wv0); ph_mod(c, B, lds); ph_dftm2(c, B, lds); }
    { const Ctx& c = ctx(); const Blk B = mkblk(wv0); ph_wprep_small(c, B, lds); ph_wprep_fourier(c, B, lds); }
    { const Ctx& c = ctx(); const Blk B = mkblk(wv0); wait_mod(c, B); }
    { const Ctx& c = ctx(); const Blk B = mkblk(wv0); ph_router_const(c, B); ph_u(c, B, lds); }
    GSYNC();
    { const Ctx& c = ctx(); const Blk B = mkblk(wv0); ph_gemm1(c, B, lds_raw); }
    GSYNC();
    { const Ctx& c = ctx(); const Blk B = mkblk(wv0); ph_dft_edge(c, B); ph_gdn_prep(c, B, lds_raw, 0); }
    GSYNC();
    { const Ctx& c = ctx(); const Blk B = mkblk(wv0); ph_gdn_scan(c, B, lds_raw, 0); if (B.bid >= 128) { ph_gdn_prep(c, B, lds_raw, 1); __syncthreads(); } ph_dft2(c, B, lds_raw, 192); if (B.bid >= 128) wprep_gate_queue(c, B, lds_raw); }
    GSYNC();
    { const Ctx& c = ctx(); const Blk B = mkblk(wv0); ph_mergeprep2(c, B); }
    GSYNC();
    { const Ctx& c = ctx(); const Blk B = mkblk(wv0); ph_merge_ab(c, B, lds_raw); }
    GSYNC();
    { const Ctx& c = ctx(); const Blk B = mkblk(wv0); ph_merge_c(c, B, lds_raw); }
    GSYNC();
    { const Ctx& c = ctx(); const Blk B = mkblk(wv0); ph_router_fast(c, B, lds_raw); }
    { const Ctx& c = ctx(); const Blk B = mkblk(wv0); ph_wprep_moe(c, B, lds); }
    GSYNC();
    { const Ctx& c = ctx(); const Blk B = mkblk(wv0); ph_moe_gu(c, B, lds_raw); wprep_down_queue(c, B, lds_raw); }
    GSYNC();
    { const Ctx& c = ctx(); const Blk B = mkblk(wv0); ph_moe_down(c, B, lds_raw); }
    GSYNC();
    { const Ctx& c = ctx(); const Blk B = mkblk(wv0); ph_final(c, B, lds); }
}

extern "C" void kernel_launch(void* const* d_in, const int* in_sizes, int n_in, void* d_out, int out_size, void* d_ws, size_t ws_size, hipStream_t stream) {
    static int grid = 0;
    if (grid == 0) {
        if (n_in != 25 || ws_size < (size_t)512 * MiB || out_size != NT * D) { fprintf(stderr, "kernel_launch: unexpected sizes n_in %d ws %zu (need %zu) out %d\n", n_in, ws_size, (size_t)WS_NEED, out_size); grid = -1; return; }
        int dev = 0, cus = 0, per_cu = 0;
        if (hipGetDevice(&dev) != hipSuccess || hipDeviceGetAttribute(&cus, hipDeviceAttributeMultiprocessorCount, dev) != hipSuccess) { grid = -1; return; }
        if (hipFuncSetAttribute((const void*)mega, hipFuncAttributeMaxDynamicSharedMemorySize, LDS_BYTES) != hipSuccess) { fprintf(stderr, "kernel_launch: hipFuncSetAttribute failed\n"); grid = -1; return; }
        if (hipOccupancyMaxActiveBlocksPerMultiprocessor(&per_cu, (const void*)mega, 512, LDS_BYTES) != hipSuccess || per_cu < 1) { fprintf(stderr, "kernel_launch: occupancy query failed (%d)\n", per_cu); (void)hipGetLastError(); per_cu = 1; }
        grid = cus * 1;
        fprintf(stderr, "kernel_launch: cus %d per_cu %d grid %d ws %zu\n", cus, per_cu, grid, ws_size);
    }
    if (grid < 0) return;
    (void)hipMemsetAsync((char*)d_ws + WS_CTL, 0, 64 * 1024, stream);
    Ctx c{};
    const float** p = (const float**)&c;
    for (int i = 0; i < 25; ++i) p[i] = (const float*)d_in[i];
    c.out = (float*)d_out; c.ws = (char*)d_ws;
    void* args[] = {&c};
    hipError_t e = hipLaunchCooperativeKernel((const void*)mega, dim3(grid), dim3(512), args, LDS_BYTES, stream);
    if (e != hipSuccess) fprintf(stderr, "kernel_launch: cooperative launch failed: %s (grid %d)\n", hipGetErrorString(e), grid);
}
```
